# Optimizing an MI355X kernel written in HIP

```python
import math
import jax, jax.numpy as jnp
from jax import lax
import numpy as np

D_MODEL = 2048
BATCH = 16
SEQ = 256
DEPTH = 4
DEC_BATCH = 8
DEC_SEQ = 4096
PAST_LEN = 512

GRID_W = 64
N_MIXERS = 3
N_ATTN = (DEPTH + 2) // 3
N_SSD = (DEPTH + 1) // 3
N_LRU = DEPTH // 3
HEAD_DIM = 128
N_HEADS = D_MODEL // HEAD_DIM
N_KV_HEADS = 4
Q_PER_KV = N_HEADS // N_KV_HEADS
QKV_DIM = (N_HEADS + 2 * N_KV_HEADS) * HEAD_DIM
ROPE_THETA = 10000.0
Q_BLOCK = 128
SSD_D_INNER = 2 * D_MODEL
SSD_HEAD_DIM = 64
SSD_HEADS = SSD_D_INNER // SSD_HEAD_DIM
SSD_GROUPS = 8
SSD_HEADS_PER_GROUP = SSD_HEADS // SSD_GROUPS
SSD_STATE = 128
SSD_CHUNK = 128
SSD_CONV_DIM = SSD_D_INNER + 2 * SSD_GROUPS * SSD_STATE
SSD_IN_DIM = SSD_D_INNER + SSD_CONV_DIM + 2 * SSD_HEADS
CONV_WIDTH = 4
LRU_WIDTH = D_MODEL
LRU_BLOCKS = 16
LRU_BLOCK_W = LRU_WIDTH // LRU_BLOCKS
LRU_C = 8.0
D_FF = -(-8 * D_MODEL // (3 * 256)) * 256
EPS = 1e-6

kernel_name = 'hybrid_prefix_diffusion_step'

F32 = jnp.float32


def rms_norm(x, g):
    xf = x.astype(F32)
    y = xf * lax.rsqrt(jnp.mean(xf * xf, axis=-1, keepdims=True) + EPS)
    return (y * g.astype(F32)).astype(x.dtype)


def adaln(cond, w, b):
    m = (jax.nn.silu(cond) @ w + b)[:, None, :]
    return jnp.split(m, 6, axis=-1)


def modulate(h, shift, scale):
    return h * (1 + scale) + shift


def axial_rope(rows):
    row = jnp.repeat(jnp.arange(rows, dtype=F32), GRID_W)
    col = jnp.tile(jnp.arange(GRID_W, dtype=F32), rows)
    n_freq = HEAD_DIM // 4
    inv = ROPE_THETA ** (-jnp.arange(n_freq, dtype=F32) / n_freq)
    ang = jnp.concatenate([row[:, None] * inv, col[:, None] * inv], axis=-1)
    return jnp.cos(ang), jnp.sin(ang)


def apply_rope(x, cos, sin):
    xf = x.astype(F32)
    x1, x2 = jnp.split(xf, 2, axis=-1)
    c, s = cos[None, :, None, :], sin[None, :, None, :]
    return jnp.concatenate([x1 * c - x2 * s, x2 * c + x1 * s], axis=-1).astype(x.dtype)


def blocked_attention(q, k, v):
    b, lq = q.shape[:2]
    nb = lq // Q_BLOCK
    qb = jnp.moveaxis(q.reshape((b, nb, Q_BLOCK) + q.shape[2:]), 1, 0)
    scale = HEAD_DIM ** -0.5

    def one_block(q_blk):
        s = jnp.einsum('bqkgd,bskd->bkgqs', q_blk, k).astype(F32) * scale
        p = jax.nn.softmax(s, axis=-1).astype(v.dtype)
        return jnp.einsum('bkgqs,bskd->bqkgd', p, v)

    o = lax.map(one_block, qb)
    return jnp.moveaxis(o, 0, 1).reshape(b, lq, N_HEADS * HEAD_DIM)


def attention_mixer(h, w_qkv, q_norm, k_norm, w_o, rope=None, k_ctx=None, v_ctx=None):
    b, l, _ = h.shape
    q, k, v = jnp.split(h @ w_qkv, [N_HEADS * HEAD_DIM, (N_HEADS + N_KV_HEADS) * HEAD_DIM], axis=-1)
    q = rms_norm(q.reshape(b, l, N_HEADS, HEAD_DIM), q_norm)
    k = rms_norm(k.reshape(b, l, N_KV_HEADS, HEAD_DIM), k_norm)
    v = v.reshape(b, l, N_KV_HEADS, HEAD_DIM)
    if rope is None:
        k_all, v_all = k, v
    else:
        q = apply_rope(q, *rope)
        k = apply_rope(k, *rope)
        k_all = jnp.concatenate([k, k_ctx], axis=1)
        v_all = jnp.concatenate([v, v_ctx], axis=1)
    o = blocked_attention(q.reshape(b, l, N_KV_HEADS, Q_PER_KV, HEAD_DIM), k_all, v_all)
    return o @ w_o, k, v


def centred_dwconv(x, w, bias):
    l = x.shape[1]
    left = (CONV_WIDTH - 1) // 2
    xp = jnp.pad(x, ((0, 0), (left, CONV_WIDTH - 1 - left), (0, 0)))
    return sum(xp[:, t:t + l] * w[t] for t in range(CONV_WIDTH)) + bias


def ssd_chunk_scan(x, dt, a, bm, cm, h0):
    b, l = x.shape[:2]
    nc = l // SSD_CHUNK
    G, HG = SSD_GROUPS, SSD_HEADS_PER_GROUP

    def to_chunks(t):
        return jnp.swapaxes(t.reshape((b, nc, SSD_CHUNK) + t.shape[2:]), 0, 1)

    xc = to_chunks(x.reshape(b, l, G, HG, SSD_HEAD_DIM))
    dtc = to_chunks(dt.reshape(b, l, G, HG))
    bc, cc = to_chunks(bm), to_chunks(cm)
    ag = a.reshape(G, HG)
    causal = jnp.tril(jnp.ones((SSD_CHUNK, SSD_CHUNK), dtype=bool))[None, :, :, None, None]

    def step(state, inp):
        x_k, dt_k, b_k, c_k = inp
        cum = jnp.cumsum(dt_k * ag, axis=1)
        seg = cum[:, :, None] - cum[:, None, :]
        decay = jnp.exp(jnp.where(causal, seg, -jnp.inf))
        scores = jnp.einsum('bign,bjgn->bijg', c_k, b_k)
        xdt = x_k * dt_k[..., None]
        y_intra = jnp.einsum('bijg,bijgh,bjghp->bighp', scores, decay, xdt)
        y_inter = jnp.einsum('bign,bghpn->bighp', c_k, state) * jnp.exp(cum)[..., None]
        to_end = jnp.exp(cum[:, -1:] - cum)
        state = state * jnp.exp(cum[:, -1])[..., None, None] + jnp.einsum('bjgh,bjghp,bjgn->bghpn', to_end, xdt, b_k)
        return state, y_intra + y_inter

    state0 = h0.astype(F32).reshape(b, G, HG, SSD_HEAD_DIM, SSD_STATE)
    h_T, ys = lax.scan(step, state0, (xc, dtc, bc, cc))
    y = jnp.swapaxes(ys, 0, 1).reshape(b, l, SSD_HEADS, SSD_HEAD_DIM)
    return y, h_T.reshape(b, SSD_HEADS, SSD_HEAD_DIM, SSD_STATE)


def ssd_mixer(h, h0_f, h0_b, w_in, conv_w, conv_b, dt_bias, a_log, d_skip, norm_w, w_out):
    b, l, _ = h.shape
    z, xbc, dt_raw = jnp.split(h @ w_in, [SSD_D_INNER, SSD_D_INNER + SSD_CONV_DIM], axis=-1)
    xbc = jax.nn.silu(centred_dwconv(xbc, conv_w, conv_b))
    xv, bm, cm = jnp.split(xbc, [SSD_D_INNER, SSD_D_INNER + SSD_GROUPS * SSD_STATE], axis=-1)
    xv = xv.reshape(b, l, SSD_HEADS, SSD_HEAD_DIM).astype(F32)
    bm = bm.reshape(b, l, SSD_GROUPS, SSD_STATE).astype(F32)
    cm = cm.reshape(b, l, SSD_GROUPS, SSD_STATE).astype(F32)
    dt = jax.nn.softplus(dt_raw.reshape(b, l, 2, SSD_HEADS).astype(F32) + dt_bias.astype(F32))
    a = -jnp.exp(a_log.astype(F32))
    y_f, h_f = ssd_chunk_scan(xv, dt[:, :, 0], a[0], bm, cm, h0_f)
    flip = lambda t: jnp.flip(t, axis=1)
    y_b, h_b = ssd_chunk_scan(flip(xv), flip(dt[:, :, 1]), a[1], flip(bm), flip(cm), h0_b)
    y = y_f + flip(y_b) + xv * d_skip.astype(F32)[:, None]
    y = y.reshape(b, l, SSD_D_INNER).astype(h.dtype)
    y = rms_norm(y * jax.nn.silu(z), norm_w)
    return y @ w_out, h_f.astype(h.dtype), h_b.astype(h.dtype)


def linear_recurrence(a, u, h0, reverse):
    first = -1 if reverse else 0
    u = u.at[:, first].add(a[:, first] * h0)

    def combine(e1, e2):
        a1, u1 = e1
        a2, u2 = e2
        return a1 * a2, a2 * u1 + u2

    _, hs = lax.associative_scan(combine, (a, u), reverse=reverse, axis=1)
    return hs, hs[:, 0] if reverse else hs[:, -1]


def rglru_mixer(h, h0_f, h0_b, w_in, conv_w, conv_b, w_a, b_a, w_i, b_i, a_param, w_out):
    b, l, _ = h.shape
    gate_branch, rec = jnp.split(h @ w_in, 2, axis=-1)
    rec = centred_dwconv(rec, conv_w, conv_b)
    rec_blk = rec.reshape(b, l, LRU_BLOCKS, LRU_BLOCK_W)
    rec32 = rec.astype(F32)
    outs, finals = [], []
    for d, h0 in enumerate((h0_f, h0_b)):
        r = jax.nn.sigmoid((jnp.einsum('blnw,nwv->blnv', rec_blk, w_a[d]).reshape(b, l, LRU_WIDTH) + b_a[d]).astype(F32))
        ig = jax.nn.sigmoid((jnp.einsum('blnw,nwv->blnv', rec_blk, w_i[d]).reshape(b, l, LRU_WIDTH) + b_i[d]).astype(F32))
        log_a = -LRU_C * r * jax.nn.softplus(-a_param[d].astype(F32))
        a = jnp.exp(log_a)
        u = jnp.sqrt(-jnp.expm1(2.0 * log_a)) * (ig * rec32)
        hs, h_T = linear_recurrence(a, u, h0.astype(F32), reverse=(d == 1))
        outs.append(hs)
        finals.append(h_T.astype(h.dtype))
    y = (outs[0] + outs[1]).astype(h.dtype) * jax.nn.gelu(gate_branch)
    return y @ w_out, finals[0], finals[1]


def swiglu_ffn(h, w_in, w_out):
    g, u = jnp.split(h @ w_in, 2, axis=-1)
    return (jax.nn.silu(g) * u) @ w_out


def setup_inputs(seed: int = 0) -> dict:
    key = jax.random.key(seed)
    keys = iter(jax.random.split(key, 48))
    D = D_MODEL

    def normal(shape, scale):
        return jax.random.normal(next(keys), shape, F32) * scale

    def uniform(shape, lo, hi):
        return jax.random.uniform(next(keys), shape, F32, lo, hi)

    x_prompt = normal((BATCH, SEQ, D), 1.0)
    x_sample = normal((DEC_BATCH, DEC_SEQ, D), 1.0)
    cache_k = normal((DEC_BATCH, N_ATTN, PAST_LEN, N_KV_HEADS, HEAD_DIM), 1.0)
    cache_v = normal((DEC_BATCH, N_ATTN, PAST_LEN, N_KV_HEADS, HEAD_DIM), 1.0)
    state_ssm = normal((DEC_BATCH, N_SSD, 2, SSD_HEADS, SSD_HEAD_DIM, SSD_STATE), 0.1)
    state_lru = normal((DEC_BATCH, N_LRU, 2, LRU_WIDTH), 0.5)
    c = normal((DEC_BATCH, D), 1.0)
    c_ctx = normal((D,), 1.0)
    ada_w = normal((DEPTH, D, 6 * D), 0.5 * D ** -0.5)
    ada_b = normal((DEPTH, 6 * D), 0.02)
    norm_mix = 1.0 + normal((DEPTH, D), 0.02)
    norm_ffn = 1.0 + normal((DEPTH, D), 0.02)
    attn_w_qkv = normal((N_ATTN, D, QKV_DIM), D ** -0.5)
    attn_q_norm = 1.0 + normal((N_ATTN, HEAD_DIM), 0.02)
    attn_k_norm = 1.0 + normal((N_ATTN, HEAD_DIM), 0.02)
    attn_w_o = normal((N_ATTN, N_HEADS * HEAD_DIM, D), (N_HEADS * HEAD_DIM) ** -0.5)
    ssd_w_in = normal((N_SSD, D, SSD_IN_DIM), D ** -0.5)
    ssd_conv_w = normal((N_SSD, CONV_WIDTH, SSD_CONV_DIM), CONV_WIDTH ** -0.5)
    ssd_conv_b = normal((N_SSD, SSD_CONV_DIM), 0.02)
    dt0 = jnp.exp(uniform((N_SSD, 2, SSD_HEADS), math.log(1e-3), math.log(1e-1)))
    ssd_dt_bias = dt0 + jnp.log(-jnp.expm1(-dt0))
    ssd_a_log = jnp.log(uniform((N_SSD, 2, SSD_HEADS), 1.0, 16.0))
    ssd_d = 1.0 + normal((N_SSD, SSD_HEADS), 0.1)
    ssd_norm = 1.0 + normal((N_SSD, SSD_D_INNER), 0.02)
    ssd_w_out = normal((N_SSD, SSD_D_INNER, D), SSD_D_INNER ** -0.5)
    lru_w_in = normal((N_LRU, D, 2 * LRU_WIDTH), D ** -0.5)
    lru_conv_w = normal((N_LRU, CONV_WIDTH, LRU_WIDTH), CONV_WIDTH ** -0.5)
    lru_conv_b = normal((N_LRU, LRU_WIDTH), 0.02)
    lru_w_a = normal((N_LRU, 2, LRU_BLOCKS, LRU_BLOCK_W, LRU_BLOCK_W), LRU_BLOCK_W ** -0.5)
    lru_b_a = normal((N_LRU, 2, LRU_WIDTH), 0.02)
    lru_w_i = normal((N_LRU, 2, LRU_BLOCKS, LRU_BLOCK_W, LRU_BLOCK_W), LRU_BLOCK_W ** -0.5)
    lru_b_i = normal((N_LRU, 2, LRU_WIDTH), 0.02)
    a0 = uniform((N_LRU, 2, LRU_WIDTH), 0.9, 0.999)
    s0 = a0 ** (1.0 / LRU_C)
    lru_a_param = jnp.log(s0) - jnp.log1p(-s0)
    lru_w_out = normal((N_LRU, LRU_WIDTH, D), LRU_WIDTH ** -0.5)
    ffn_w_in = normal((DEPTH, D, 2 * D_FF), D ** -0.5)
    ffn_w_out = normal((DEPTH, D_FF, D), D_FF ** -0.5)
    final_norm = 1.0 + normal((D,), 0.02)
    return {'x_prompt': x_prompt, 'x_sample': x_sample, 'cache_k': cache_k, 'cache_v': cache_v,
            'state_ssm': state_ssm, 'state_lru': state_lru, 'c': c, 'c_ctx': c_ctx,
            'ada_w': ada_w, 'ada_b': ada_b, 'norm_mix': norm_mix, 'norm_ffn': norm_ffn,
            'attn_w_qkv': attn_w_qkv, 'attn_q_norm': attn_q_norm, 'attn_k_norm': attn_k_norm, 'attn_w_o': attn_w_o,
            'ssd_w_in': ssd_w_in, 'ssd_conv_w': ssd_conv_w, 'ssd_conv_b': ssd_conv_b, 'ssd_dt_bias': ssd_dt_bias,
            'ssd_a_log': ssd_a_log, 'ssd_d': ssd_d, 'ssd_norm': ssd_norm, 'ssd_w_out': ssd_w_out,
            'lru_w_in': lru_w_in, 'lru_conv_w': lru_conv_w, 'lru_conv_b': lru_conv_b, 'lru_w_a': lru_w_a,
            'lru_b_a': lru_b_a, 'lru_w_i': lru_w_i, 'lru_b_i': lru_b_i, 'lru_a_param': lru_a_param,
            'lru_w_out': lru_w_out, 'ffn_w_in': ffn_w_in, 'ffn_w_out': ffn_w_out, 'final_norm': final_norm}


def reference(x_prompt, x_sample, cache_k, cache_v, state_ssm, state_lru, c, c_ctx,
              ada_w, ada_b, norm_mix, norm_ffn,
              attn_w_qkv, attn_q_norm, attn_k_norm, attn_w_o,
              ssd_w_in, ssd_conv_w, ssd_conv_b, ssd_dt_bias, ssd_a_log, ssd_d, ssd_norm, ssd_w_out,
              lru_w_in, lru_conv_w, lru_conv_b, lru_w_a, lru_b_a, lru_w_i, lru_b_i, lru_a_param, lru_w_out,
              ffn_w_in, ffn_w_out, final_norm):
    xp, xs = x_prompt, x_sample
    bp = xp.shape[0]
    rows = xs.shape[1] // GRID_W
    rope = axial_rope(rows)
    new_k, new_v, new_ssm, new_lru = [], [], [], []
    for i in range(DEPTH):
        kind, j = i % N_MIXERS, i // N_MIXERS
        p_sh1, p_sc1, p_g1, p_sh2, p_sc2, p_g2 = adaln(c_ctx[None, :], ada_w[i], ada_b[i])
        s_sh1, s_sc1, s_g1, s_sh2, s_sc2, s_g2 = adaln(c, ada_w[i], ada_b[i])
        hp = modulate(rms_norm(xp, norm_mix[i]), p_sh1, p_sc1)
        hs = modulate(rms_norm(xs, norm_mix[i]), s_sh1, s_sc1)
        if kind == 0:
            op, k_ctx, v_ctx = attention_mixer(hp, attn_w_qkv[j], attn_q_norm[j], attn_k_norm[j], attn_w_o[j])
            os_, _, _ = attention_mixer(hs, attn_w_qkv[j], attn_q_norm[j], attn_k_norm[j], attn_w_o[j],
                                        rope=rope, k_ctx=cache_k[:, j], v_ctx=cache_v[:, j])
            new_k.append(k_ctx)
            new_v.append(v_ctx)
        elif kind == 1:
            zero = jnp.zeros((bp, SSD_HEADS, SSD_HEAD_DIM, SSD_STATE), F32)
            w = (ssd_w_in[j], ssd_conv_w[j], ssd_conv_b[j], ssd_dt_bias[j], ssd_a_log[j], ssd_d[j], ssd_norm[j], ssd_w_out[j])
            op, h_f, h_b = ssd_mixer(hp, zero, zero, *w)
            os_, _, _ = ssd_mixer(hs, state_ssm[:, j, 0], state_ssm[:, j, 1], *w)
            new_ssm.append(jnp.stack([h_f, h_b], axis=1))
        else:
            zero = jnp.zeros((bp, LRU_WIDTH), F32)
            w = (lru_w_in[j], lru_conv_w[j], lru_conv_b[j], lru_w_a[j], lru_b_a[j], lru_w_i[j], lru_b_i[j], lru_a_param[j], lru_w_out[j])
            op, h_f, h_b = rglru_mixer(hp, zero, zero, *w)
            os_, _, _ = rglru_mixer(hs, state_lru[:, j, 0], state_lru[:, j, 1], *w)
            new_lru.append(jnp.stack([h_f, h_b], axis=1))
        xp = xp + p_g1 * op
        xs = xs + s_g1 * os_
        xp = xp + p_g2 * swiglu_ffn(modulate(rms_norm(xp, norm_ffn[i]), p_sh2, p_sc2), ffn_w_in[i], ffn_w_out[i])
        xs = xs + s_g2 * swiglu_ffn(modulate(rms_norm(xs, norm_ffn[i]), s_sh2, s_sc2), ffn_w_in[i], ffn_w_out[i])
    y_prompt = rms_norm(xp, final_norm)
    y_sample = rms_norm(xs, final_norm)
    new_cache_k = jnp.stack(new_k, axis=1)
    new_cache_v = jnp.stack(new_v, axis=1)
    new_state_ssm = jnp.stack(new_ssm, axis=1)
    new_state_lru = jnp.stack(new_lru, axis=1)
    return (y_prompt, y_sample, new_cache_k, new_cache_v, new_state_ssm, new_state_lru)
```

```cpp
#include <hip/hip_runtime.h>
#include <cstdio>
#include <cstdint>

#ifndef MK_SINGLE
#define MK_SINGLE 1
#endif

#ifndef REP_FFN1
#define REP_FFN1 1
#endif
#ifndef REP_ATT
#define REP_ATT 1
#endif
#ifndef REP_SSDSCAN
#define REP_SSDSCAN 1
#endif
#ifndef REP_LRUSCAN
#define REP_LRUSCAN 1
#endif
#ifndef REP_NORM
#define REP_NORM 1
#endif
#ifndef REP_QKV
#define REP_QKV 1
#endif
#ifndef REP_SSDIN
#define REP_SSDIN 1
#endif
#ifndef REP_P0
#define REP_P0 1
#endif
#ifndef WGM_N2048
#define WGM_N2048 4
#endif
#ifndef WGM_FFN1
#define WGM_FFN1 4
#endif
#ifndef ENMASK
#define ENMASK 0xFFFFFFFFu
#endif
#define EN(b) ((ENMASK >> (b)) & 1u)
#define LAS __attribute__((address_space(3)))
#define GAS __attribute__((address_space(1)))
typedef unsigned short bf16_t;
typedef short bf16x8 __attribute__((ext_vector_type(8)));
typedef short s16x4 __attribute__((ext_vector_type(4)));
typedef float f32x4 __attribute__((ext_vector_type(4)));
typedef float f32x2 __attribute__((ext_vector_type(2)));
typedef float f32x16 __attribute__((ext_vector_type(16)));
typedef unsigned u32x4 __attribute__((ext_vector_type(4)));
typedef unsigned u32x2 __attribute__((ext_vector_type(2)));

constexpr int DM = 2048, MP = 4096, MS = 32768, MT = MP + MS;
constexpr int NQKV = 3072, DFF = 5632, NFFN = 11264;
constexpr int SSD_NPAD = 10496, SSD_ZX = 10240, SSD_DI = 4096, SSD_XBC = 6144;
constexpr int PAST = 512, LKS = 4096 + PAST;
constexpr float EPS = 1e-6f;
constexpr int NWAVES = 8, NTHREADS = 512;

constexpr size_t MiB = 1u << 20;
constexpr size_t WS_CTL = 0, CTL_ZERO_BYTES = 1 * MiB;
constexpr size_t WS_MOD = 1 * MiB;
constexpr size_t WS_GM = 3 * MiB + 64 * 1024;
constexpr size_t WS_ROPE = 3 * MiB;
constexpr size_t WS_RGM = 9 * MiB + 256 * 1024;
constexpr size_t WS_HALO = 4 * MiB;
constexpr size_t WS_DT = 10 * MiB;
constexpr size_t WS_RSS = 28 * MiB;
constexpr size_t RSS_BYTES = (size_t)10 * 36864 * 4;
constexpr size_t WS_BIAS = 29 * MiB + 512 * 1024;
constexpr int BO_QKV = 0, BO_SSD = 2 * 9 * 3072, BO_LRU = BO_SSD + 9 * 10496, BO_FFN = BO_LRU + 9 * 4096, BO_FFN_SZ = 9 * 11264;
constexpr size_t WS_W = 32 * MiB;
constexpr size_t W_QKV = WS_W, W_QKV_SZ = (size_t)NQKV * DM * 2;
constexpr size_t W_O = W_QKV + 2 * W_QKV_SZ, W_O_SZ = (size_t)DM * DM * 2;
constexpr size_t W_SSDIN = W_O + 2 * W_O_SZ, W_SSDIN_SZ = (size_t)SSD_NPAD * DM * 2;
constexpr size_t W_SSDOUT = W_SSDIN + W_SSDIN_SZ, W_SSDOUT_SZ = (size_t)DM * SSD_DI * 2;
constexpr size_t W_LRUIN = W_SSDOUT + W_SSDOUT_SZ, W_LRUIN_SZ = (size_t)4096 * DM * 2;
constexpr size_t W_LRUOUT = W_LRUIN + W_LRUIN_SZ, W_LRUOUT_SZ = (size_t)DM * DM * 2;
constexpr size_t W_LRUG = W_LRUOUT + W_LRUOUT_SZ, W_LRUG_SZ = (size_t)64 * 128 * 128 * 2;
constexpr size_t W_FFNIN = W_LRUG + W_LRUG_SZ, W_FFNIN_SZ = (size_t)NFFN * DM * 2;
constexpr size_t W_FFNOUT = W_FFNIN + 4 * W_FFNIN_SZ, W_FFNOUT_SZ = (size_t)DM * DFF * 2;
constexpr size_t W_END = W_FFNOUT + 4 * W_FFNOUT_SZ;
constexpr size_t WS_H = 420 * MiB;
constexpr size_t WS_X16 = WS_H + 144 * MiB;
constexpr size_t WS_BIG = 708 * MiB;
constexpr size_t WS_END = WS_BIG + 720 * MiB;
static_assert(W_END <= WS_H, "weights overflow");
constexpr size_t B_QKV = WS_BIG, B_O = WS_BIG + 216 * MiB, B_KS = WS_BIG + 360 * MiB, B_VS = WS_BIG + 396 * MiB, B_KP = WS_BIG + 432 * MiB, B_VP = WS_BIG + 436 * MiB;
constexpr size_t B_ACT = WS_BIG;
constexpr size_t B_ZX = WS_BIG;
constexpr size_t B_GR = WS_BIG, B_YL = WS_BIG + 288 * MiB;
constexpr int CW_BAR = 4096;

constexpr size_t O_X = 0, O_CK = (size_t)MT * DM, O_CV = O_CK + (size_t)16 * 2 * 256 * 512, O_SSM = O_CV + (size_t)16 * 2 * 256 * 512,
                 O_LRU = O_SSM + (size_t)16 * 2 * 64 * 64 * 128, O_END = O_LRU + (size_t)16 * 2 * 2048;

constexpr int RING_BYTES = 131072, MISC_OFF = RING_BYTES + 320, LDS_BYTES = 147456;

#define LDS_WAIT() asm volatile("s_waitcnt lgkmcnt(0)" ::: "memory")
#define VM_WAIT() asm volatile("s_waitcnt vmcnt(0)" ::: "memory")
#define LBAR() do { asm volatile("s_waitcnt lgkmcnt(0)" ::: "memory"); __builtin_amdgcn_s_barrier(); asm volatile("" ::: "memory"); } while (0)

__device__ __forceinline__ int lane_id() { return (int)__builtin_amdgcn_mbcnt_hi(~0u, __builtin_amdgcn_mbcnt_lo(~0u, 0u)); }
__device__ __forceinline__ int opaque_tid(int wv) { asm volatile("" : "+s"(wv)); int t = wv * 64 + lane_id(); asm volatile("" : "+v"(t)); return t; }
__device__ __forceinline__ unsigned cvt_pk_bf16(float lo, float hi) { unsigned r; asm volatile("v_cvt_pk_bf16_f32 %0, %1, %2" : "=v"(r) : "v"(lo), "v"(hi)); return r; }
__device__ __forceinline__ float bf_lo(unsigned w) { return __uint_as_float(w << 16); }
__device__ __forceinline__ float bf_hi(unsigned w) { return __uint_as_float(w & 0xffff0000u); }
__device__ __forceinline__ float silu_f(float x) { return x * __builtin_amdgcn_rcpf(1.0f + __expf(-x)); }
__device__ __forceinline__ float wave_sum(float v) {
#pragma unroll
    for (int o = 1; o < 64; o <<= 1) v += __shfl_xor(v, o);
    return v;
}

#define XB_TMO      128
#define XB_XCNT(j)  (256  + 64 * (j))
#define XB_XSUB(j)  (1280 + 64 * (j))
#define XB_XGEN(j)  (2304 + 64 * (j))
#define XB_TOP      3328
#define XB_TOPGEN   3392
#define XCD_BAR_WORDS 3456
#define XB_SPIN_CAP (1u << 22)
__device__ __forceinline__ unsigned xb_ld(unsigned* p)              { return __hip_atomic_load(p, __ATOMIC_RELAXED, __HIP_MEMORY_SCOPE_AGENT); }
__device__ __forceinline__ unsigned xb_add(unsigned* p, unsigned v) { return __hip_atomic_fetch_add(p, v, __ATOMIC_RELAXED, __HIP_MEMORY_SCOPE_AGENT); }
__device__ __forceinline__ unsigned xb_xcc_id() { return (unsigned)__builtin_amdgcn_s_getreg((3 << 11) | 20) & 0xFu; }
#define XB_SPIN(cond, bar) do { unsigned _sp = 0; while (cond) { __builtin_amdgcn_s_sleep(1); \
    if ((++_sp & 255u) == 0u) { if (xb_ld(&(bar)[XB_TMO])) break; if (_sp > XB_SPIN_CAP) { atomicAdd(&(bar)[XB_TMO], 1u); break; } } } } while (0)
struct XcdBarrier { unsigned* bar; unsigned x; volatile LAS unsigned* st; int wv; };
__device__ __forceinline__ XcdBarrier xcd_barrier_post(unsigned* bar, volatile LAS unsigned* st, int wv) {
    XcdBarrier b; b.bar = bar; b.x = xb_xcc_id(); b.st = st; b.wv = wv;
    if (threadIdx.x == 0) (void)xb_add(&bar[XB_XCNT(b.x)], 1u);
    return b;
}
__device__ __forceinline__ void xcd_barrier_complete(unsigned* bar, unsigned x, unsigned& nloc, unsigned& nx) {
    const unsigned G = gridDim.x * gridDim.y * gridDim.z;
    unsigned sum, cnt, mine, sp = 0u;
    for (;;) {
        sum = 0u; cnt = 0u; mine = 0u;
#pragma unroll
        for (unsigned j = 0; j < 16; ++j) { const unsigned c = xb_ld(&bar[XB_XCNT(j)]); sum += c; cnt += (c > 0u) ? 1u : 0u; mine = (j == x) ? c : mine; }
        if (sum == G) break;
        __builtin_amdgcn_s_sleep(1);
        if ((++sp & 255u) == 0u) { if (xb_ld(&bar[XB_TMO])) break; if (sp > XB_SPIN_CAP) { atomicAdd(&bar[XB_TMO], 1u); break; } }
    }
    nloc = mine > 0u ? mine : 1u; nx = cnt > 0u ? cnt : 1u;
}
__device__ __forceinline__ void xcd_barrier(const XcdBarrier& b) {
    asm volatile("s_waitcnt vmcnt(0)" ::: "memory");
    __syncthreads();
    if (b.wv == 0 && lane_id() == 0) {
        unsigned* bar = b.bar;
        __builtin_amdgcn_s_waitcnt(0);
        unsigned nloc = b.st[0], nx = b.st[1];
        if (nloc == 0u) { xcd_barrier_complete(bar, b.x, nloc, nx); b.st[0] = nloc; b.st[1] = nx; }
        const unsigned old = xb_add(&bar[XB_XSUB(b.x)], 1u);
        const unsigned gen = old / nloc;
        if (old + 1u == (gen + 1u) * nloc) {
            __builtin_amdgcn_fence(__ATOMIC_RELEASE, "agent");
            asm volatile("s_waitcnt vmcnt(0)" ::: "memory");
            const unsigned og = xb_add(&bar[XB_TOP], 1u);
            const unsigned tg = og / nx;
            if (og + 1u == (tg + 1u) * nx) xb_add(&bar[XB_TOPGEN], 1u);
            else XB_SPIN(xb_ld(&bar[XB_TOPGEN]) == tg, bar);
            __builtin_amdgcn_fence(__ATOMIC_ACQUIRE, "agent");
            xb_add(&bar[XB_XGEN(b.x)], 1u);
            asm volatile("s_waitcnt vmcnt(0)" ::: "memory");
        } else {
            XB_SPIN(xb_ld(&bar[XB_XGEN(b.x)]) == gen, bar);
            __builtin_amdgcn_fence(__ATOMIC_ACQUIRE, "agent");
            asm volatile("s_waitcnt vmcnt(0)" ::: "memory");
        }
    }
    __syncthreads();
}

namespace pg8 {
constexpr int STAGE_SLOT_OFF = RING_BYTES + 1024, STAGE_SLOT_BYTES = 3072;
constexpr int BM = 256, BK = 64, HALF = 128, HTB = HALF * BK * 2, STAGE_BYTES = 8 * HTB, NXCD = 8, WGM = 4;
__host__ __device__ __forceinline__ int lds_byte(int r, int c) { const int st = (r >> 4) * 2 + (c >> 5), rr = r & 15, cc = c & 31, ob = rr * 64 + cc * 2; return st * 1024 + (ob ^ (((ob >> 9) & 1) << 5)); }
__host__ __device__ __forceinline__ void stage_rc(int b, int& R, int& C) { const int st = b / 1024, sb = b % 1024, swz = sb ^ (((sb >> 9) & 1) << 5); R = (st >> 1) * 16 + swz / 64; C = (st & 1) * 32 + (swz % 64) / 2; }
__host__ __device__ __forceinline__ int perm32(int rho) { const int n = rho >> 4, i = rho & 15; return 8 * (i >> 2) + 4 * n + (i & 3); }
struct Unit { int pm, pn; };
struct Gemm { const bf16_t* A; const bf16_t* Bt; int M, N, K, lda; };
struct StaticOrder {
    int nM, nN, nwg, G, c, wgm;
    __host__ __device__ void init(int M, int N, int G_, int c_, int wgm_ = WGM) { nM = M / BM; nN = N / BM; nwg = nM * nN; G = G_; c = c_; wgm = wgm_; }
    __host__ __device__ bool next(int i, Unit& u) const {
        const long L = (long)i * G + c; if (L >= nwg) return false;
        int wgid = (int)L; { const int q = nwg / NXCD, r = nwg % NXCD, xcd = wgid % NXCD, off = wgid / NXCD; wgid = (xcd < r ? xcd * (q + 1) : r * (q + 1) + (xcd - r) * q) + off; }
        const int nig = wgm * nN, gid = wgid / nig, fm = gid * wgm, gsz = (nM - fm) < wgm ? (nM - fm) : wgm;
        u.pm = fm + ((wgid % nig) % gsz); u.pn = (wgid % nig) / gsz; return true;
    }
    __device__ __forceinline__ void a_ready(const Unit&) const {}
    __device__ __forceinline__ void done(const Unit&) const {}
};
template <class Epi, class Sched, bool ALIGN_EPI = false, bool SP2 = false>
__device__ __forceinline__ void gemm_phase(LAS unsigned char* lds, const Gemm g, const Sched& S, const Epi& E, const int wv_) {
    const int tid = opaque_tid(wv_), wid = __builtin_amdgcn_readfirstlane(tid >> 6), lane = tid & 63, wr = wid >> 2, wc = wid & 3, fr = lane & 15, fq = lane >> 4;
    const int K = g.K, nt = K / BK, lda = g.lda;
    unsigned voffA[2], voffB[2];
#pragma unroll
    for (int i = 0; i < 2; ++i) { int R, C; stage_rc(tid * 16 + i * 8192, R, C); const int Rb = Epi::PERM ? ((R & ~31) + perm32(R & 31)) : R;
        voffA[i] = (unsigned)(R * lda + C) * 2u; voffB[i] = (unsigned)(Rb * K + C) * 2u; }
    const size_t kstep = (size_t)(BK * 2);
    const size_t hstepA = (size_t)HALF * lda * 2, hstepB = (size_t)HALF * K * 2;
    const size_t tstepA = 2 * hstepA, tstepB = 2 * hstepB;
    const unsigned ldsw = (unsigned)wid * 1024u;
    const int aoff = lds_byte(wr * 64 + fr, fq * 8), boff = lds_byte(wc * 32 + fr, fq * 8);
#define PG8_SA(b, h) (((b) * 2 + (h)) * HTB)
#define PG8_SB(b, h) ((4 + (b) * 2 + (h)) * HTB)
#define PG8_STAGE(bufoff, gbase, voff) do { _Pragma("unroll") for (int _i = 0; _i < 2; ++_i) { unsigned vo_ = (voff)[_i]; asm volatile("" : "+v"(vo_));     \
        __builtin_amdgcn_global_load_lds((const unsigned*)((const char*)(gbase) + vo_), (LAS unsigned*)(lds + (bufoff) + ldsw + _i * 8192), 16, 0, 0); } } while (0)
#define PG8_LDA(dst, b, h) do { _Pragma("unroll") for (int m = 0; m < 4; ++m) _Pragma("unroll") for (int k = 0; k < 2; ++k) dst[m][k] = *(const LAS bf16x8*)(lds + PG8_SA(b, h) + aoff + m * 2048 + k * 1024); } while (0)
#define PG8_LDB(dst, b, h) do { _Pragma("unroll") for (int n = 0; n < 2; ++n) _Pragma("unroll") for (int k = 0; k < 2; ++k) dst[n][k] = *(const LAS bf16x8*)(lds + PG8_SB(b, h) + boff + n * 2048 + k * 1024); } while (0)
#define PG8_MMA(ai, bj, At, Bt) do { __builtin_amdgcn_s_setprio(1); _Pragma("unroll") for (int m = 0; m < 4; ++m) _Pragma("unroll") for (int n = 0; n < 2; ++n) _Pragma("unroll") for (int k = 0; k < 2; ++k) \
        acc[ai][bj][m][n] = __builtin_amdgcn_mfma_f32_16x16x32_bf16(Bt[n][k], At[m][k], acc[ai][bj][m][n], 0, 0, 0); __builtin_amdgcn_s_setprio(0); } while (0)
#define PG8_WAIT_V(n) asm volatile("s_waitcnt vmcnt(" #n ")" ::: "memory")
#define PG8_WAIT_L(n) asm volatile("s_waitcnt lgkmcnt(" #n ")" ::: "memory")
#define PG8_BAR __builtin_amdgcn_s_barrier()
#define PG8_SCHED __builtin_amdgcn_sched_barrier(0)
    Unit cur, nxt; int ui = 0;
    if (!S.next(0, cur)) return;
    f32x4 acc[2][2][4][2];
#pragma unroll
    for (int a = 0; a < 2; ++a)
#pragma unroll
        for (int b = 0; b < 2; ++b)
#pragma unroll
            for (int m = 0; m < 4; ++m)
#pragma unroll
                for (int n = 0; n < 2; ++n) acc[a][b][m][n] = (f32x4){0.f, 0.f, 0.f, 0.f};
    bf16x8 At[4][2], B0[2][2], B1[2][2];
    const char* cA = (const char*)g.A + (size_t)cur.pm * tstepA; const char* cB = (const char*)g.Bt + (size_t)cur.pn * tstepB;
    S.a_ready(cur);
    if constexpr (SP2) {
        PG8_STAGE(PG8_SB(0, 0), cB, voffB); PG8_STAGE(PG8_SB(0, 1), cB + hstepB, voffB); PG8_STAGE(PG8_SA(0, 0), cA, voffA); PG8_STAGE(PG8_SA(0, 1), cA + hstepA, voffA);
        if (wr == 1) PG8_BAR;
        PG8_WAIT_V(2); PG8_BAR;
        PG8_STAGE(PG8_SB(1, 0), cB + kstep, voffB); PG8_STAGE(PG8_SA(1, 0), cA + kstep, voffA); PG8_STAGE(PG8_SB(1, 1), cB + hstepB + kstep, voffB);
        PG8_WAIT_V(6); PG8_BAR;
    } else {
        PG8_STAGE(PG8_SB(0, 0), cB, voffB); PG8_STAGE(PG8_SA(0, 0), cA, voffA); PG8_STAGE(PG8_SB(0, 1), cB + hstepB, voffB); PG8_STAGE(PG8_SA(0, 1), cA + hstepA, voffA);
        if (wr == 1) PG8_BAR;
        PG8_WAIT_V(4); PG8_BAR;
        PG8_STAGE(PG8_SB(1, 0), cB + kstep, voffB); PG8_STAGE(PG8_SA(1, 0), cA + kstep, voffA); PG8_STAGE(PG8_SB(1, 1), cB + hstepB + kstep, voffB);
        PG8_WAIT_V(6); PG8_BAR;
    }
    for (;;) {
        const bool has_next = S.next(ui + 1, nxt);
        const char* nA = has_next ? (const char*)g.A + (size_t)nxt.pm * tstepA : cA; const char* nB = has_next ? (const char*)g.Bt + (size_t)nxt.pn * tstepB : cB;
        for (int t = 0; t < nt; t += 2) {
            const bool last = (t == nt - 2);
            const char* a1 = cA + (size_t)(t + 1) * kstep;
            const char* a2 = last ? nA : cA + (size_t)(t + 2) * kstep; const char* b2 = last ? nB : cB + (size_t)(t + 2) * kstep;
            const char* a3 = a2 + kstep; const char* b3 = b2 + kstep;
            if (last && has_next) S.a_ready(nxt);
            if constexpr (Epi::STAGED) { if (t == 0) { __builtin_amdgcn_global_load_lds((const unsigned*)E.stage_src(cur, tid), (LAS unsigned*)(lds + STAGE_SLOT_OFF + (ui & 1) * STAGE_SLOT_BYTES + wid * 256), 4, 0, 0);
                if constexpr (Epi::STAGED3) { if (wid < 4) __builtin_amdgcn_global_load_lds((const unsigned*)E.stage_src3(cur, tid), (LAS unsigned*)(lds + STAGE_SLOT_OFF + (ui & 1) * STAGE_SLOT_BYTES + 2048 + wid * 256), 4, 0, 0); } } }
            if constexpr (SP2) {
            PG8_LDB(B0, 0, 0); PG8_LDB(B1, 0, 1); PG8_SCHED; PG8_LDA(At, 0, 0); PG8_STAGE(PG8_SA(1, 1), a1 + hstepA, voffA);
            PG8_WAIT_V(8); PG8_WAIT_L(0); PG8_BAR; PG8_MMA(0, 0, At, B0); PG8_MMA(0, 1, At, B1); PG8_BAR; PG8_SCHED;
            PG8_LDA(At, 0, 1); PG8_STAGE(PG8_SB(0, 0), b2, voffB); PG8_STAGE(PG8_SB(0, 1), b2 + hstepB, voffB); PG8_STAGE(PG8_SA(0, 0), a2, voffA);
            PG8_WAIT_V(8); PG8_WAIT_L(0); PG8_BAR; PG8_MMA(1, 0, At, B0); PG8_MMA(1, 1, At, B1); PG8_BAR; PG8_SCHED;
            PG8_LDB(B0, 1, 0); PG8_LDB(B1, 1, 1); PG8_SCHED; PG8_LDA(At, 1, 0); PG8_STAGE(PG8_SA(0, 1), a2 + hstepA, voffA);
            PG8_WAIT_V(8); PG8_WAIT_L(0); PG8_BAR; PG8_MMA(0, 0, At, B0); PG8_MMA(0, 1, At, B1); PG8_BAR; PG8_SCHED;
            PG8_LDA(At, 1, 1); PG8_STAGE(PG8_SB(1, 0), b3, voffB); PG8_STAGE(PG8_SB(1, 1), b3 + hstepB, voffB); PG8_STAGE(PG8_SA(1, 0), a3, voffA);
            PG8_WAIT_V(8); PG8_WAIT_L(0); PG8_BAR; PG8_MMA(1, 0, At, B0); PG8_MMA(1, 1, At, B1); PG8_BAR; PG8_SCHED;
            } else {
            PG8_LDB(B0, 0, 0); PG8_SCHED; PG8_LDA(At, 0, 0); PG8_STAGE(PG8_SA(1, 1), a1 + hstepA, voffA);
            PG8_WAIT_L(8); PG8_BAR; PG8_WAIT_L(0); PG8_MMA(0, 0, At, B0); PG8_BAR; PG8_SCHED;
            PG8_LDB(B1, 0, 1); PG8_STAGE(PG8_SB(0, 0), b2, voffB);
            PG8_BAR; PG8_WAIT_L(0); PG8_MMA(0, 1, At, B1); PG8_BAR;
            PG8_LDA(At, 0, 1); PG8_STAGE(PG8_SA(0, 0), a2, voffA);
            PG8_BAR; PG8_WAIT_L(0); PG8_MMA(1, 0, At, B0); PG8_BAR; PG8_SCHED;
            PG8_STAGE(PG8_SB(0, 1), b2 + hstepB, voffB);
            PG8_WAIT_V(6); PG8_BAR; PG8_MMA(1, 1, At, B1); PG8_BAR;
            PG8_LDB(B0, 1, 0); PG8_SCHED; PG8_LDA(At, 1, 0); PG8_STAGE(PG8_SA(0, 1), a2 + hstepA, voffA);
            PG8_WAIT_L(8); PG8_BAR; PG8_WAIT_L(0); PG8_MMA(0, 0, At, B0); PG8_BAR; PG8_SCHED;
            PG8_LDB(B1, 1, 1); PG8_STAGE(PG8_SB(1, 0), b3, voffB);
            PG8_BAR; PG8_WAIT_L(0); PG8_MMA(0, 1, At, B1); PG8_BAR;
            PG8_LDA(At, 1, 1); PG8_STAGE(PG8_SA(1, 0), a3, voffA);
            PG8_BAR; PG8_WAIT_L(0); PG8_MMA(1, 0, At, B0); PG8_BAR; PG8_SCHED;
            PG8_STAGE(PG8_SB(1, 1), b3 + hstepB, voffB);
            PG8_WAIT_V(6); PG8_BAR; PG8_MMA(1, 1, At, B1); PG8_BAR;
            }
        }
        if constexpr (ALIGN_EPI) { if (wr == 0) PG8_BAR; }
        E(acc, cur, wr, wc, fr, fq, (const LAS float*)(lds + STAGE_SLOT_OFF + (ui & 1) * STAGE_SLOT_BYTES)); S.done(cur);
        if (!has_next) break;
#pragma unroll
        for (int a = 0; a < 2; ++a)
#pragma unroll
            for (int b = 0; b < 2; ++b)
#pragma unroll
                for (int m = 0; m < 4; ++m)
#pragma unroll
                    for (int n = 0; n < 2; ++n) acc[a][b][m][n] = (f32x4){0.f, 0.f, 0.f, 0.f};
        cur = nxt; cA = nA; cB = nB; ++ui;
        if constexpr (ALIGN_EPI) { if (wr == 1) PG8_BAR; }
    }
    PG8_WAIT_V(0);
    if constexpr (!ALIGN_EPI) { if (wr == 0) PG8_BAR; }
    PG8_BAR;
#undef PG8_SA
#undef PG8_SB
#undef PG8_STAGE
#undef PG8_LDA
#undef PG8_LDB
#undef PG8_MMA
#undef PG8_WAIT_V
#undef PG8_WAIT_L
#undef PG8_BAR
#undef PG8_SCHED
}

struct RowMod {
    const float* rss;
    const float* bias;
    int nb;
    __device__ __forceinline__ const float* src(const Unit& u, int tid) const {
        const int ci = u.pm < 16 ? 8 : ((u.pm - 16) >> 4);
        return tid < 256 ? rss + u.pm * BM + tid : bias + (size_t)ci * nb + u.pn * BM + (tid - 256);
    }
    static __device__ __forceinline__ void rstd8(float (&rs)[2][4], const LAS float* slot, int rl0) {
#pragma unroll
        for (int ai = 0; ai < 2; ++ai)
#pragma unroll
            for (int m = 0; m < 4; ++m) rs[ai][m] = 1.0f / sqrtf(slot[rl0 + ai * HALF + m * 16] * (1.0f / DM) + EPS);
    }
    static __device__ __forceinline__ void bias8(f32x4 (&bv)[2][2], const LAS float* slot, int cl0) {
#pragma unroll
        for (int bj = 0; bj < 2; ++bj) { bv[bj][0] = *(const LAS f32x4*)(slot + 256 + cl0 + bj * HALF); bv[bj][1] = *(const LAS f32x4*)(slot + 256 + cl0 + bj * HALF + 4); }
    }
};
struct EpiBf16 {
    static constexpr bool PERM = true;
    static constexpr bool STAGED = true, STAGED3 = false;
    bf16_t* O; int ldc; bf16_t* halo; int halo_col0, halo_ld; RowMod rm;
    __device__ __forceinline__ const float* stage_src(const Unit& u, int tid) const { return rm.src(u, tid); }
    __device__ __forceinline__ void operator()(const f32x4 (&acc)[2][2][4][2], const Unit& u, int wr, int wc, int fr, int fq, const LAS float* slot) const {
        const int row0 = u.pm * BM + wr * 64 + fr; const int col0 = u.pn * BM + wc * 32 + 8 * fq;
        float rs[2][4]; RowMod::rstd8(rs, slot, wr * 64 + fr); f32x4 bv[2][2]; RowMod::bias8(bv, slot, wc * 32 + 8 * fq);
#pragma unroll
        for (int ai = 0; ai < 2; ++ai)
#pragma unroll
            for (int m = 0; m < 4; ++m) { bf16_t* rowp = O + (size_t)(row0 + ai * HALF + m * 16) * ldc + col0;
#pragma unroll
                for (int bj = 0; bj < 2; ++bj) { const f32x4 v0 = acc[ai][bj][m][0] * rs[ai][m] + bv[bj][0], v1 = acc[ai][bj][m][1] * rs[ai][m] + bv[bj][1];
                    u32x4 w; w.x = cvt_pk_bf16(v0[0], v0[1]); w.y = cvt_pk_bf16(v0[2], v0[3]); w.z = cvt_pk_bf16(v1[0], v1[1]); w.w = cvt_pk_bf16(v1[2], v1[3]);
                    *(u32x4*)(rowp + bj * HALF) = w;
                    if (halo != nullptr && col0 >= halo_col0) {
                        const int rl = wr * 64 + fr + ai * HALF + m * 16;
                        const int hs = rl == 0 ? 0 : (rl == 1 ? 1 : (rl == 255 ? 2 : -1));
                        if (hs >= 0) *(u32x4*)(halo + ((size_t)u.pm * 3 + hs) * halo_ld + (col0 - halo_col0) + bj * HALF) = w;
                    } } }
    }
};
struct EpiSsdIn {
    static constexpr bool PERM = true;
    static constexpr bool STAGED = true, STAGED3 = false;
    bf16_t* O; bf16_t* halo; float* dt; RowMod rm;
    __device__ __forceinline__ const float* stage_src(const Unit& u, int tid) const { return rm.src(u, tid); }
    __device__ __forceinline__ void operator()(const f32x4 (&acc)[2][2][4][2], const Unit& u, int wr, int wc, int fr, int fq, const LAS float* slot) const {
        if (u.pn < 40) { EpiBf16 e{O, SSD_ZX, halo, SSD_DI, SSD_XBC, rm}; e(acc, u, wr, wc, fr, fq, slot); return; }
        const int row0 = u.pm * BM + wr * 64 + fr; const int col0 = wc * 32 + 8 * fq;
        float rs[2][4]; RowMod::rstd8(rs, slot, wr * 64 + fr); f32x4 bv[2][2]; RowMod::bias8(bv, slot, col0);
#pragma unroll
        for (int ai = 0; ai < 2; ++ai)
#pragma unroll
            for (int m = 0; m < 4; ++m) { float* rowp = dt + (size_t)(row0 + ai * HALF + m * 16) * 128 + col0;
                *(f32x4*)(rowp) = acc[ai][0][m][0] * rs[ai][m] + bv[0][0]; *(f32x4*)(rowp + 4) = acc[ai][0][m][1] * rs[ai][m] + bv[0][1]; }
    }
};
struct EpiSwiGLU {
    static constexpr bool PERM = true;
    static constexpr bool STAGED = true, STAGED3 = false;
    bf16_t* O; RowMod rm;
    __device__ __forceinline__ const float* stage_src(const Unit& u, int tid) const { return rm.src(u, tid); }
    __device__ __forceinline__ void operator()(const f32x4 (&acc)[2][2][4][2], const Unit& u, int wr, int wc, int fr, int fq, const LAS float* slot) const {
        const int row0 = u.pm * BM + wr * 64 + fr; const int col0 = u.pn * HALF + wc * 32 + 8 * fq;
        float rs[2][4]; RowMod::rstd8(rs, slot, wr * 64 + fr); f32x4 bv[2][2]; RowMod::bias8(bv, slot, wc * 32 + 8 * fq);
#pragma unroll
        for (int ai = 0; ai < 2; ++ai)
#pragma unroll
            for (int m = 0; m < 4; ++m) { bf16_t* rowp = O + (size_t)(row0 + ai * HALF + m * 16) * DFF + col0;
                float r[8];
#pragma unroll
                for (int n = 0; n < 2; ++n)
#pragma unroll
                    for (int e = 0; e < 4; ++e) r[n * 4 + e] = silu_f(acc[ai][0][m][n][e] * rs[ai][m] + bv[0][n][e]) * (acc[ai][1][m][n][e] * rs[ai][m] + bv[1][n][e]);
                u32x4 w; w.x = cvt_pk_bf16(r[0], r[1]); w.y = cvt_pk_bf16(r[2], r[3]); w.z = cvt_pk_bf16(r[4], r[5]); w.w = cvt_pk_bf16(r[6], r[7]);
                *(u32x4*)rowp = w; }
    }
};
template <bool XF32>
struct EpiResid {
    static constexpr bool PERM = true, STAGED = true, STAGED3 = true;
    const float* xin_p; const float* xin_s; bf16_t* x16; const float* gate;
    bf16_t* xg_in; bf16_t* xg_out; const float* gmv; const float* rgmv; float* rss_out;
    const float* rs_in; float rs_inv_n;
    __device__ __forceinline__ const float* stage_src(const Unit& u, int tid) const {
        const int ci = u.pm < 16 ? 8 : ((u.pm - 16) >> 4);
        const float* g = gate + (size_t)ci * 12288 + u.pn * BM;
        return tid < 256 ? g + tid : (xg_out != nullptr ? gmv + (size_t)ci * 2048 + u.pn * BM + (tid - 256) : g + (tid - 256));
    }
    __device__ __forceinline__ const float* stage_src3(const Unit& u, int tid) const {
        const int ci = u.pm < 16 ? 8 : ((u.pm - 16) >> 4);
        return XF32 ? gate + (size_t)ci * 12288 + u.pn * BM + tid : rgmv + (size_t)ci * 2048 + u.pn * BM + tid;
    }
    __device__ __forceinline__ void finish(const f32x4 (&nx)[2], float& ss, size_t ro, int bj, int row0, int cl0, const LAS float* slot) const {
        ss += (nx[0][0] * nx[0][0] + nx[0][1] * nx[0][1]) + (nx[0][2] * nx[0][2] + nx[0][3] * nx[0][3]);
        ss += (nx[1][0] * nx[1][0] + nx[1][1] * nx[1][1]) + (nx[1][2] * nx[1][2] + nx[1][3] * nx[1][3]);
        if (xg_out != nullptr) { const f32x4 a = nx[0] * *(const LAS f32x4*)(slot + 256 + cl0 + bj * HALF), b = nx[1] * *(const LAS f32x4*)(slot + 256 + cl0 + bj * HALF + 4);
            u32x4 w; w.x = cvt_pk_bf16(a[0], a[1]); w.y = cvt_pk_bf16(a[2], a[3]); w.z = cvt_pk_bf16(b[0], b[1]); w.w = cvt_pk_bf16(b[2], b[3]);
            *(u32x4*)(xg_out + (size_t)row0 * DM + ro + bj * HALF) = w; }
        else { u32x4 w16; w16.x = cvt_pk_bf16(nx[0][0], nx[0][1]); w16.y = cvt_pk_bf16(nx[0][2], nx[0][3]); w16.z = cvt_pk_bf16(nx[1][0], nx[1][1]); w16.w = cvt_pk_bf16(nx[1][2], nx[1][3]);
            *(u32x4*)(x16 + (size_t)row0 * DM + ro + bj * HALF) = w16; }
    }
    __device__ __forceinline__ void operator()(const f32x4 (&acc)[2][2][4][2], const Unit& u, int wr, int wc, int fr, int fq, const LAS float* slot) const {
        const int row0 = u.pm * BM + wr * 64 + fr, col0 = u.pn * BM + wc * 32 + 8 * fq, cl0 = wc * 32 + 8 * fq;
        float rsc[2][4];
#pragma unroll
        for (int ai = 0; ai < 2; ++ai)
#pragma unroll
            for (int m = 0; m < 4; ++m) rsc[ai][m] = rs_in ? 1.0f / sqrtf(rs_in[row0 + ai * HALF + m * 16] * rs_inv_n + EPS) : 1.0f;
        if constexpr (XF32) {
            const float* xi = (u.pm < 16) ? xin_p + (size_t)row0 * DM : xin_s + (size_t)(row0 - MP) * DM;
#pragma unroll
            for (int ai = 0; ai < 2; ++ai) {
                f32x4 xv[4][2][2];
#pragma unroll
                for (int m = 0; m < 4; ++m) { const size_t ro = (size_t)(ai * HALF + m * 16) * DM + col0;
#pragma unroll
                    for (int bj = 0; bj < 2; ++bj)
#pragma unroll
                        for (int n = 0; n < 2; ++n) xv[m][bj][n] = *(const f32x4*)(xi + ro + bj * HALF + n * 4); }
                asm volatile("" ::: "memory");
#pragma unroll
                for (int m = 0; m < 4; ++m) { const size_t ro = (size_t)(ai * HALF + m * 16) * DM + col0; float ss = 0.f;
#pragma unroll
                    for (int bj = 0; bj < 2; ++bj) { f32x4 nx[2];
#pragma unroll
                        for (int n = 0; n < 2; ++n) { const f32x4 gv = *(const LAS f32x4*)(slot + cl0 + bj * HALF + n * 4); nx[n] = xv[m][bj][n] + gv * (acc[ai][bj][m][n] * rsc[ai][m]); }
                        finish(nx, ss, ro, bj, row0, cl0, slot); }
                    ss += __shfl_xor(ss, 16); ss += __shfl_xor(ss, 32);
                    if (fq == 0) atomicAdd(rss_out + row0 + ai * HALF + m * 16, rintf(ss * 16.f) * 0.0625f); }
                asm volatile("" ::: "memory"); }
        } else {
            const bf16_t* xi = xg_in + (size_t)row0 * DM;
#pragma unroll
            for (int ai = 0; ai < 2; ++ai) {
                u32x4 xr[4][2];
#pragma unroll
                for (int m = 0; m < 4; ++m)
#pragma unroll
                    for (int bj = 0; bj < 2; ++bj) xr[m][bj] = *(const u32x4*)(xi + (size_t)(ai * HALF + m * 16) * DM + col0 + bj * HALF);
                asm volatile("" ::: "memory");
#pragma unroll
                for (int m = 0; m < 4; ++m) { const size_t ro = (size_t)(ai * HALF + m * 16) * DM + col0; float ss = 0.f;
#pragma unroll
                    for (int bj = 0; bj < 2; ++bj) { const u32x4 raw = xr[m][bj]; f32x4 nx[2];
                        const f32x4 x0 = {bf_lo(raw.x), bf_hi(raw.x), bf_lo(raw.y), bf_hi(raw.y)}, x1 = {bf_lo(raw.z), bf_hi(raw.z), bf_lo(raw.w), bf_hi(raw.w)};
                        nx[0] = x0 * *(const LAS f32x4*)(slot + 512 + cl0 + bj * HALF) + *(const LAS f32x4*)(slot + cl0 + bj * HALF) * (acc[ai][bj][m][0] * rsc[ai][m]);
                        nx[1] = x1 * *(const LAS f32x4*)(slot + 512 + cl0 + bj * HALF + 4) + *(const LAS f32x4*)(slot + cl0 + bj * HALF + 4) * (acc[ai][bj][m][1] * rsc[ai][m]);
                        finish(nx, ss, ro, bj, row0, cl0, slot); }
                    ss += __shfl_xor(ss, 16); ss += __shfl_xor(ss, 32);
                    if (fq == 0) atomicAdd(rss_out + row0 + ai * HALF + m * 16, rintf(ss * 16.f) * 0.0625f); }
                asm volatile("" ::: "memory"); }
        }
    }
};
}

namespace att {
constexpr int D = 128, NW = 8, QBLK = 32, KVBLK = 64;
constexpr float SCALE = 0.088388347648318440f;
constexpr float THR = 8.f;
constexpr int LDQ = NQKV, LDK = 512, LDV = NQKV, LDO = DM;
constexpr size_t SHM_V = KVBLK * D * 2, SHM_K = KVBLK * D * 2, SHM_ATTN = 2 * SHM_V + 2 * SHM_K + NW * 64 * 4;
#define KSWZ(row, colB) ((row) * 256 + ((colB) ^ (((row) & 7) << 4)))
#define SBAR() __builtin_amdgcn_sched_barrier(0)
__device__ __forceinline__ int crow(int r, int hi) { return (r & 3) + 8 * (r >> 2) + 4 * hi; }
__device__ __forceinline__ void partialSM(f32x16& p0, f32x16& p1, float& m_reg, float& mn, float& alpha) {
  constexpr float C = SCALE * 1.4426950408889634f;
  float pmax = p0[0]; for (int r = 1; r < 16; ++r) pmax = fmaxf(pmax, p0[r]); for (int r = 0; r < 16; ++r) pmax = fmaxf(pmax, p1[r]);
  { auto rr = __builtin_amdgcn_permlane32_swap(__float_as_uint(pmax), __float_as_uint(pmax), false, false);
    pmax = fmaxf(__uint_as_float(rr[0]), __uint_as_float(rr[1])); }
  if (__builtin_expect(__all(pmax - m_reg <= THR / SCALE), 1)) { mn = m_reg; alpha = 1.f; }
  else { mn = fmaxf(m_reg, pmax); alpha = __builtin_amdgcn_exp2f((m_reg - mn) * C); m_reg = mn; }
  float mnC = -mn * C;
  for (int r = 0; r < 16; ++r) p0[r] = fmaf(p0[r], C, mnC); for (int r = 0; r < 16; ++r) p1[r] = fmaf(p1[r], C, mnC);
  for (int r = 0; r < 16; ++r) p0[r] = __builtin_amdgcn_exp2f(p0[r]);
}
__device__ __forceinline__ void finishSM(f32x16& p0, f32x16& p1, float alpha, float& l_reg, bf16x8& pa0, bf16x8& pa1, bf16x8& pa2, bf16x8& pa3) {
  for (int r = 0; r < 16; ++r) p1[r] = __builtin_amdgcn_exp2f(p1[r]);
  float ps = 0; for (int r = 0; r < 16; ++r) ps += p0[r]; for (int r = 0; r < 16; ++r) ps += p1[r];
  { auto rr = __builtin_amdgcn_permlane32_swap(__float_as_uint(ps), __float_as_uint(ps), false, false);
    ps = __uint_as_float(rr[0]) + __uint_as_float(rr[1]); }
  l_reg = l_reg * alpha + ps;
#define PK4(P, BASE, OUT) do { unsigned a0 = cvt_pk_bf16(P[BASE + 0], P[BASE + 1]), a1 = cvt_pk_bf16(P[BASE + 2], P[BASE + 3]);   \
    unsigned b0 = cvt_pk_bf16(P[BASE + 4], P[BASE + 5]), b1 = cvt_pk_bf16(P[BASE + 6], P[BASE + 7]);                              \
    auto r0 = __builtin_amdgcn_permlane32_swap(a0, b0, false, false); auto r1 = __builtin_amdgcn_permlane32_swap(a1, b1, false, false); \
    u32x4 w = {r0[0], r1[0], r0[1], r1[1]}; OUT = *reinterpret_cast<bf16x8*>(&w); } while (0)
  PK4(p0, 0, pa0); PK4(p0, 8, pa1); PK4(p1, 0, pa2); PK4(p1, 8, pa3);
}
__device__ __forceinline__ void qkt(f32x16& p0, f32x16& p1, const bf16_t* Ks, const bf16x8* qr, int r32, int hi) {
  p0 = f32x16{}; p1 = f32x16{};
  for (int d0 = 0; d0 < 8; ++d0) { int cb = (d0 * 16 + hi * 8) * 2;
    bf16x8 b0 = *reinterpret_cast<const bf16x8*>((const char*)Ks + KSWZ(r32, cb));
    bf16x8 b1 = *reinterpret_cast<const bf16x8*>((const char*)Ks + KSWZ(32 + r32, cb));
    p0 = __builtin_amdgcn_mfma_f32_32x32x16_bf16(b0, qr[d0], p0, 0, 0, 0);
    p1 = __builtin_amdgcn_mfma_f32_32x32x16_bf16(b1, qr[d0], p1, 0, 0, 0); }
}
__device__ __forceinline__ int v_st(int k, int c) { const int kk = (k & ~0xC) | ((k & 4) << 1) | ((k & 8) >> 1); return ((kk >> 3) * 4 + (c >> 5)) * 512 + ((kk & 7) * 32 + (c & 31)) * 2; }
__device__ __forceinline__ int v_rd_base(int lane) { return ((lane & 3) << 3) | (((lane >> 2) & 3) << 6) | (((lane >> 4) & 1) << 5) | (((lane >> 5) & 1) << 8); }
constexpr int v_rd_off(int d0, int ks, int half) { return d0 * 512 + ks * 4096 + half * 2048; }
template <int OFF> __device__ __forceinline__ s16x4 tr_read(int vb) {
  s16x4 r; asm volatile("ds_read_b64_tr_b16 %0, %1 offset:%2" : "=&v"(r) : "v"(vb), "i"(OFF) : "memory"); return r;
}
template <int D0> __device__ __forceinline__ void pv_one(f32x16& od, int vb, bf16x8 pa0, bf16x8 pa1, bf16x8 pa2, bf16x8 pa3) {
  const s16x4 l0 = tr_read<v_rd_off(D0, 0, 0)>(vb), h0 = tr_read<v_rd_off(D0, 0, 1)>(vb), l1 = tr_read<v_rd_off(D0, 1, 0)>(vb), h1 = tr_read<v_rd_off(D0, 1, 1)>(vb);
  const s16x4 l2 = tr_read<v_rd_off(D0, 2, 0)>(vb), h2 = tr_read<v_rd_off(D0, 2, 1)>(vb), l3 = tr_read<v_rd_off(D0, 3, 0)>(vb), h3 = tr_read<v_rd_off(D0, 3, 1)>(vb);
  asm volatile("s_waitcnt lgkmcnt(0)" ::: "memory"); SBAR();
#define PK(L, H) (bf16x8){L[0], L[1], L[2], L[3], H[0], H[1], H[2], H[3]}
  od = __builtin_amdgcn_mfma_f32_32x32x16_bf16(pa0, PK(l0, h0), od, 0, 0, 0);
  od = __builtin_amdgcn_mfma_f32_32x32x16_bf16(pa1, PK(l1, h1), od, 0, 0, 0);
  od = __builtin_amdgcn_mfma_f32_32x32x16_bf16(pa2, PK(l2, h2), od, 0, 0, 0);
  od = __builtin_amdgcn_mfma_f32_32x32x16_bf16(pa3, PK(l3, h3), od, 0, 0, 0);
#undef PK
}
__device__ __forceinline__ void pv_d0(f32x16* o, int vb, bf16x8 pa0, bf16x8 pa1, bf16x8 pa2, bf16x8 pa3) {
  pv_one<0>(o[0], vb, pa0, pa1, pa2, pa3); pv_one<1>(o[1], vb, pa0, pa1, pa2, pa3); pv_one<2>(o[2], vb, pa0, pa1, pa2, pa3); pv_one<3>(o[3], vb, pa0, pa1, pa2, pa3);
}
__device__ __forceinline__ void attn_dense_body(const bf16_t* __restrict__ Qb, const bf16_t* __restrict__ Kh, const bf16_t* __restrict__ Vh,
                                                bf16_t* __restrict__ Ob, int seq, char* lds, const int wv_) {
  constexpr int SDEPTH = 2;
  const int tid = opaque_tid(wv_), wid = tid >> 6, lane = tid & 63, r32 = lane & 31, hi = lane >> 5;
  bf16_t* V_lds = (bf16_t*)lds; bf16_t* K_lds = (bf16_t*)(lds + 2 * SHM_V);
  float* ws = (float*)(lds + 2 * SHM_V + 2 * SHM_K) + wid * 64; float* li_l = ws; float* al_l = ws + 32;
  float m_reg = -1e30f, l_reg = 0; f32x16 o[4] = {}; bf16x8 qr[8];
  const bf16_t* Qw = Qb + (long)(wid * QBLK + r32) * LDQ + hi * 8;
#pragma unroll
  for (int d0 = 0; d0 < 8; ++d0) qr[d0] = *reinterpret_cast<const bf16x8*>(Qw + d0 * 16);
  const int sr = tid >> 4, sc = (tid & 15) * 8, vst0 = v_st(sr, sc), vst1 = v_st(32 + sr, sc);
  const int vb0 = (int)(uintptr_t)V_lds + v_rd_base(lane);
  struct { bf16x8 vs0, vs1, ks0, ks1; } sr_[SDEPTH];
#define LD8(p) (*reinterpret_cast<const bf16x8*>(p))
#define SLOAD(i, k0) do { sr_[i].vs0 = LD8(&Vh[(long)((k0) + sr) * LDK + sc]); sr_[i].vs1 = LD8(&Vh[(long)((k0) + 32 + sr) * LDK + sc]); \
    sr_[i].ks0 = LD8(&Kh[(long)((k0) + sr) * LDK + sc]); sr_[i].ks1 = LD8(&Kh[(long)((k0) + 32 + sr) * LDK + sc]); } while (0)
#define SWRITE(b, i) do { *(bf16x8*)((char*)V_lds + (b) * SHM_V + vst0) = sr_[i].vs0;          \
    *(bf16x8*)((char*)V_lds + (b) * SHM_V + vst1) = sr_[i].vs1; int kc = sc * 2;               \
    *(bf16x8*)((char*)K_lds + (b) * SHM_K + KSWZ(sr, kc)) = sr_[i].ks0;                       \
    *(bf16x8*)((char*)K_lds + (b) * SHM_K + KSWZ(32 + sr, kc)) = sr_[i].ks1; } while (0)
#define SWAIT() do { asm volatile("s_waitcnt vmcnt(4)" ::: "memory"); } while (0)
#define RESC(a) do { if (__any((a) < 1.f)) { if (hi == 0) al_l[r32] = (a); asm volatile("s_waitcnt lgkmcnt(0)" ::: "memory"); \
    for (int d = 0; d < 4; ++d) for (int r = 0; r < 16; ++r) o[d][r] *= al_l[crow(r, hi)]; } } while (0)
  f32x16 pA0, pA1, pB0, pB1; float mnA, mnB, alA, alB; bf16x8 pa0, pa1, pa2, pa3; const int NT = seq / KVBLK;
  constexpr int SE = 0, SO = SDEPTH - 1;
  SLOAD(SE, 0); asm volatile("s_waitcnt vmcnt(0)" ::: "memory"); SWRITE(0, SE); __syncthreads();
  qkt(pA0, pA1, K_lds, qr, r32, hi); partialSM(pA0, pA1, m_reg, mnA, alA);
  SLOAD(SO, KVBLK); if (2 < NT) SLOAD(SE, 2 * KVBLK);
  SWAIT(); SWRITE(1, SO); __syncthreads();
  for (int j = 1; j + 1 < NT; j += 2) {
    SBAR(); qkt(pB0, pB1, (bf16_t*)((char*)K_lds + SHM_K), qr, r32, hi);
    finishSM(pA0, pA1, alA, l_reg, pa0, pa1, pa2, pa3); SBAR();
    SLOAD(SO, (j + SDEPTH) * KVBLK); SBAR();
    pv_d0(o, vb0, pa0, pa1, pa2, pa3); partialSM(pB0, pB1, m_reg, mnB, alB);
    __syncthreads(); SWAIT(); SWRITE(0, SE);
    RESC(alB); __syncthreads();
    SBAR(); qkt(pA0, pA1, K_lds, qr, r32, hi);
    finishSM(pB0, pB1, alB, l_reg, pa0, pa1, pa2, pa3); SBAR();
    if (j + 3 < NT) SLOAD(SE, (j + 1 + SDEPTH) * KVBLK); SBAR();
    pv_d0(o, vb0 + (int)SHM_V, pa0, pa1, pa2, pa3); partialSM(pA0, pA1, m_reg, mnA, alA);
    __syncthreads(); SWAIT(); SWRITE(1, SO);
    RESC(alA); __syncthreads();
  }
  SBAR(); qkt(pB0, pB1, (bf16_t*)((char*)K_lds + SHM_K), qr, r32, hi);
  finishSM(pA0, pA1, alA, l_reg, pa0, pa1, pa2, pa3); SBAR();
  pv_d0(o, vb0, pa0, pa1, pa2, pa3); partialSM(pB0, pB1, m_reg, mnB, alB);
  __syncthreads(); RESC(alB);
  finishSM(pB0, pB1, alB, l_reg, pa0, pa1, pa2, pa3); SBAR();
  pv_d0(o, vb0 + (int)SHM_V, pa0, pa1, pa2, pa3);
  if (hi == 0) li_l[r32] = l_reg; asm volatile("s_waitcnt lgkmcnt(0)" ::: "memory");
  float rli[16];
#pragma unroll
  for (int r = 0; r < 16; ++r) rli[r] = __builtin_amdgcn_rcpf(li_l[crow(r, hi)]);
  bf16_t* Ow = Ob + (long)(wid * QBLK) * LDO;
#pragma unroll
  for (int r = 0; r < 16; ++r) { int orow = crow(r, hi);
    for (int d0 = 0; d0 < 4; ++d0) Ow[(long)orow * LDO + d0 * 32 + r32] = (bf16_t)(cvt_pk_bf16(o[d0][r] * rli[r], 0.f) & 0xffffu); }
  asm volatile("s_waitcnt vmcnt(0)" ::: "memory");
  __syncthreads();
#undef LD8
#undef SLOAD
#undef SWRITE
#undef SWAIT
#undef RESC
}

constexpr unsigned ASLOT = 32768u, AOFF_V = 16384u, AOFF_WS = RING_BYTES + 8192;
constexpr float C_L2 = SCALE * 1.4426950408889634f, THR_L2 = THR * 1.4426950408889634f;
template <bool FIRST>
__device__ __forceinline__ void partialSM2(f32x16& p0, f32x16& p1, f32x16& negm, float& alpha) {
  float pmax = p0[0]; for (int r = 1; r < 16; ++r) pmax = fmaxf(pmax, p0[r]); for (int r = 0; r < 16; ++r) pmax = fmaxf(pmax, p1[r]);
  { auto rr = __builtin_amdgcn_permlane32_swap(__float_as_uint(pmax), __float_as_uint(pmax), false, false);
    pmax = fmaxf(__uint_as_float(rr[0]), __uint_as_float(rr[1])); }
  if (FIRST) { alpha = 1.f; for (int r = 0; r < 16; ++r) { p0[r] -= pmax; p1[r] -= pmax; negm[r] = -pmax; } }
  else if (__builtin_expect(__all(pmax <= THR_L2), 1)) { alpha = 1.f; }
  else { const float d = fmaxf(pmax, 0.f); alpha = __builtin_amdgcn_exp2f(-d); for (int r = 0; r < 16; ++r) { p0[r] -= d; p1[r] -= d; negm[r] -= d; } }
  for (int r = 0; r < 16; ++r) p0[r] = __builtin_amdgcn_exp2f(p0[r]);
}
__device__ __forceinline__ void qkt2(f32x16& p0, f32x16& p1, const f32x16& negm, LAS const unsigned char* kb, unsigned kl, const bf16x8* qr) {
#pragma unroll
  for (int d0 = 0; d0 < 8; ++d0) { const unsigned a = kl ^ (32u * d0);
    const bf16x8 b0 = *(LAS const bf16x8*)(kb + a), b1 = *(LAS const bf16x8*)(kb + a + 8192);
    if (d0 == 0) { p0 = __builtin_amdgcn_mfma_f32_32x32x16_bf16(b0, qr[0], negm, 0, 0, 0); p1 = __builtin_amdgcn_mfma_f32_32x32x16_bf16(b1, qr[0], negm, 0, 0, 0); }
    else { p0 = __builtin_amdgcn_mfma_f32_32x32x16_bf16(b0, qr[d0], p0, 0, 0, 0); p1 = __builtin_amdgcn_mfma_f32_32x32x16_bf16(b1, qr[d0], p1, 0, 0, 0); } }
}
__device__ __forceinline__ void attn_dma_body(const bf16_t* __restrict__ Qb, const bf16_t* __restrict__ Kh, const bf16_t* __restrict__ Vh,
                                              bf16_t* __restrict__ Ob, int seq, LAS unsigned char* lds, const int wv_, const float* __restrict__ qnw, const f32x2* __restrict__ rope, const int tok0,
                                              const bf16_t* __restrict__ Vc, const int nown) {
  const int tid = opaque_tid(wv_), wid = __builtin_amdgcn_readfirstlane(tid >> 6), lane = tid & 63, r32 = lane & 31, hi = lane >> 5;
  LAS float* wsl = (LAS float*)(lds + AOFF_WS) + wid * 64; LAS float* li_l = wsl; LAS float* al_l = wsl + 32;
  f32x16 o[4] = {}; f32x16 negm = {}; float l_reg = 0; bf16x8 qr[8];
  const int NT = seq / KVBLK;
  unsigned kof[2], vof[2];
#pragma unroll
  for (int i = 0; i < 2; ++i) { const int row = 4 * (2 * wid + i) + (lane >> 4), ch = (lane & 15) ^ (row & 7); kof[i] = (unsigned)(row * LDK + ch * 8) * 2u;
    const int kk = 8 * wid + ((lane & 31) >> 2), k = (kk & ~0xC) | ((kk & 4) << 1) | ((kk & 8) >> 1), c = (2 * i + (lane >> 5)) * 32 + (lane & 3) * 8; vof[i] = (unsigned)(k * LDV + c) * 2u; }
#define ADMA(t) do { const unsigned so_ = ((unsigned)(t) & 3u) * ASLOT + (unsigned)wid * 2048u; const char* kg_ = (const char*)Kh + (size_t)(t) * (KVBLK * LDK * 2); const char* vg_ = ((t) < nown) ? (const char*)Vh + (size_t)(t) * (KVBLK * LDV * 2) : (const char*)Vc + (size_t)((t) - nown) * (KVBLK * LDV * 2); \
    _Pragma("unroll") for (int i_ = 0; i_ < 2; ++i_) { unsigned ko_ = kof[i_], vo_ = vof[i_]; asm volatile("" : "+v"(ko_), "+v"(vo_)); \
      __builtin_amdgcn_global_load_lds((const unsigned*)(kg_ + ko_), (LAS unsigned*)(lds + so_ + i_ * 1024), 16, 0, 0); \
      __builtin_amdgcn_global_load_lds((const unsigned*)(vg_ + vo_), (LAS unsigned*)(lds + so_ + AOFF_V + i_ * 1024), 16, 0, 0); } } while (0)
#define AWAITV(n) asm volatile("s_waitcnt vmcnt(" #n ")" ::: "memory")
#define ABAR() do { asm volatile("" ::: "memory"); __builtin_amdgcn_s_barrier(); asm volatile("" ::: "memory"); } while (0)
  const bf16_t* Qw = Qb + (long)(wid * QBLK + r32) * LDQ + hi * 8;
#pragma unroll
  for (int d0 = 0; d0 < 8; ++d0) qr[d0] = *reinterpret_cast<const bf16x8*>(Qw + d0 * 16);
  f32x4 qw4[16], rp4[16];
  { const int t = (tok0 < 0 ? 0 : tok0) + wid * QBLK + r32;
#pragma unroll
    for (int h2 = 0; h2 < 2; ++h2)
#pragma unroll
      for (int d0 = 0; d0 < 4; ++d0)
#pragma unroll
        for (int j = 0; j < 2; ++j) qw4[(h2 * 4 + d0) * 2 + j] = *(const f32x4*)(qnw + h2 * 64 + d0 * 16 + hi * 8 + 4 * j);
#pragma unroll
    for (int d0 = 0; d0 < 4; ++d0) { const f32x4* rp = (const f32x4*)(rope + ((d0 < 2) ? (t >> 6) : (t & 63)) * 32 + (d0 & 1) * 16 + hi * 8);
#pragma unroll
      for (int j = 0; j < 4; ++j) rp4[d0 * 4 + j] = rp[j]; } }
  asm volatile("" ::: "memory");
  ADMA(0); ADMA(1); ADMA(2);
  {
    float ss = 0.f;
#pragma unroll
    for (int d0 = 0; d0 < 8; ++d0)
#pragma unroll
      for (int e = 0; e < 8; ++e) { const float x = __uint_as_float(((unsigned)(unsigned short)qr[d0][e]) << 16); ss += x * x; }
    { auto rr = __builtin_amdgcn_permlane32_swap(__float_as_uint(ss), __float_as_uint(ss), false, false); ss = __uint_as_float(rr[0]) + __uint_as_float(rr[1]); }
    const float rstd = 1.0f / sqrtf(ss * (1.0f / 128.0f) + EPS);
#pragma unroll
    for (int d0 = 0; d0 < 4; ++d0) {
      float a[8], b[8];
#pragma unroll
      for (int e = 0; e < 8; ++e) { const float wa = qw4[d0 * 2 + (e >> 2)][e & 3] * C_L2, wb = qw4[(4 + d0) * 2 + (e >> 2)][e & 3] * C_L2;
        a[e] = __uint_as_float(((unsigned)(unsigned short)qr[d0][e]) << 16) * rstd * wa; b[e] = __uint_as_float(((unsigned)(unsigned short)qr[d0 + 4][e]) << 16) * rstd * wb; }
      if (tok0 >= 0) {
#pragma unroll
        for (int e = 0; e < 8; ++e) { const float c_ = rp4[d0 * 4 + (e >> 1)][(e & 1) * 2], s_ = rp4[d0 * 4 + (e >> 1)][(e & 1) * 2 + 1]; const float x = a[e], y = b[e]; a[e] = x * c_ - y * s_; b[e] = y * c_ + x * s_; } }
      u32x4 wa_, wb_;
      wa_.x = cvt_pk_bf16(a[0], a[1]); wa_.y = cvt_pk_bf16(a[2], a[3]); wa_.z = cvt_pk_bf16(a[4], a[5]); wa_.w = cvt_pk_bf16(a[6], a[7]);
      wb_.x = cvt_pk_bf16(b[0], b[1]); wb_.y = cvt_pk_bf16(b[2], b[3]); wb_.z = cvt_pk_bf16(b[4], b[5]); wb_.w = cvt_pk_bf16(b[6], b[7]);
      qr[d0] = *reinterpret_cast<bf16x8*>(&wa_); qr[d0 + 4] = *reinterpret_cast<bf16x8*>(&wb_); }
  }
  const unsigned kl = 256u * (unsigned)r32 + ((((unsigned)hi) ^ ((unsigned)r32 & 7u)) << 4);
  const unsigned vb0 = (unsigned)(uintptr_t)lds + AOFF_V + (unsigned)v_rd_base(lane);
#define KSL(t) (lds + ((unsigned)(t) & 3u) * ASLOT)
#define VSL(t) ((int)(vb0 + ((unsigned)(t) & 3u) * ASLOT))
#define RESC2(a) do { if (__any((a) < 1.f)) { if (hi == 0) al_l[r32] = (a); asm volatile("s_waitcnt lgkmcnt(0)" ::: "memory"); \
    for (int d = 0; d < 4; ++d) for (int r = 0; r < 16; ++r) o[d][r] *= al_l[crow(r, hi)]; } } while (0)
#define ASTEP_END(s) do { if ((s) + 2 < NT) AWAITV(4); else AWAITV(0); ABAR(); if ((s) + 3 < NT) ADMA((s) + 3); } while (0)
  f32x16 pA0, pA1, pB0, pB1; float alA, alB; bf16x8 pa0, pa1, pa2, pa3;
  AWAITV(8); ABAR();
  qkt2(pA0, pA1, negm, KSL(0), kl, qr); partialSM2<true>(pA0, pA1, negm, alA);
  ASTEP_END(0);
  for (int j = 1; j + 1 < NT; j += 2) {
    SBAR(); qkt2(pB0, pB1, negm, KSL(j), kl, qr);
    finishSM(pA0, pA1, alA, l_reg, pa0, pa1, pa2, pa3); SBAR();
    pv_d0(o, VSL(j - 1), pa0, pa1, pa2, pa3); partialSM2<false>(pB0, pB1, negm, alB);
    RESC2(alB); ASTEP_END(j);
    SBAR(); qkt2(pA0, pA1, negm, KSL(j + 1), kl, qr);
    finishSM(pB0, pB1, alB, l_reg, pa0, pa1, pa2, pa3); SBAR();
    pv_d0(o, VSL(j), pa0, pa1, pa2, pa3); partialSM2<false>(pA0, pA1, negm, alA);
    RESC2(alA); ASTEP_END(j + 1);
  }
  SBAR(); qkt2(pB0, pB1, negm, KSL(NT - 1), kl, qr);
  finishSM(pA0, pA1, alA, l_reg, pa0, pa1, pa2, pa3); SBAR();
  pv_d0(o, VSL(NT - 2), pa0, pa1, pa2, pa3); partialSM2<false>(pB0, pB1, negm, alB);
  RESC2(alB);
  finishSM(pB0, pB1, alB, l_reg, pa0, pa1, pa2, pa3); SBAR();
  pv_d0(o, VSL(NT - 1), pa0, pa1, pa2, pa3);
  if (hi == 0) li_l[r32] = l_reg; asm volatile("s_waitcnt lgkmcnt(0)" ::: "memory");
  ABAR();
  float rli[16];
#pragma unroll
  for (int r = 0; r < 16; ++r) rli[r] = __builtin_amdgcn_rcpf(li_l[crow(r, hi)]);
  bf16_t* Ow = Ob + (long)(wid * QBLK) * LDO;
#pragma unroll
  for (int r = 0; r < 16; ++r) { int orow = crow(r, hi);
    for (int d0 = 0; d0 < 4; ++d0) Ow[(long)orow * LDO + d0 * 32 + r32] = (bf16_t)(cvt_pk_bf16(o[d0][r] * rli[r], 0.f) & 0xffffu); }
  asm volatile("s_waitcnt lgkmcnt(0)" ::: "memory");
#undef ADMA
#undef AWAITV
#undef ABAR
#undef KSL
#undef VSL
#undef RESC2
#undef ASTEP_END
}
}

__device__ __forceinline__ void tr_item(const float* W, int ldw, int K, bf16_t* WT, int k0, int nd0, int ns0, LAS float* scr, int lane) {
    if (ns0 >= 0) {
#pragma unroll
        for (int i = 0; i < 32; ++i) { const int kk = 2 * i + (lane >> 5); scr[kk * 33 + (lane & 31)] = __builtin_nontemporal_load(&W[(size_t)(k0 + kk) * ldw + ns0 + (lane & 31)]); }
    } else {
#pragma unroll 8
        for (int i = 0; i < 32; ++i) { const int kk = 2 * i + (lane >> 5); scr[kk * 33 + (lane & 31)] = 0.f; }
    }
    LDS_WAIT(); asm volatile("" ::: "memory");
    const int c = lane & 7;
#pragma unroll
    for (int j = 0; j < 4; ++j) { const int n = (lane >> 3) + 8 * j; const LAS float* s = scr + (8 * c) * 33 + n;
        u32x4 o; o.x = cvt_pk_bf16(s[0 * 33], s[1 * 33]); o.y = cvt_pk_bf16(s[2 * 33], s[3 * 33]); o.z = cvt_pk_bf16(s[4 * 33], s[5 * 33]); o.w = cvt_pk_bf16(s[6 * 33], s[7 * 33]);
        *(u32x4*)(WT + (size_t)(nd0 + n) * K + k0 + 8 * c) = o; }
    LDS_WAIT(); asm volatile("" ::: "memory");
}
template <int MAP>
__device__ __forceinline__ void transpose_mat(const float* W, int ldw, int K, bf16_t* WT, int Ndst, LAS float* scr, int gw, int NGW, int lane, int& off) {
    const int nblk = Ndst / 32, nitems = (K / 64) * nblk;
    const int it0 = (gw + NGW - off % NGW) % NGW; off += nitems;
    for (int it = it0; it < nitems; it += NGW) {
        const int kb = it / nblk, nb = it % nblk, nd0 = nb * 32; int ns0 = nd0;
        if (MAP == 1) { const int pn = nd0 >> 8, r = nd0 & 255; ns0 = (r < 128) ? pn * 128 + r : DFF + pn * 128 + (r - 128); }
        if (MAP == 2) { if (nd0 >= 10368) ns0 = -1; }
        tr_item(W, ldw, K, WT, kb * 64, nd0, ns0, scr, lane);
    }
}

__device__ __forceinline__ void xg_init_pass(const float* xp, const float* xs, const float* gain, const float* mod, int sc_off, bf16_t* XG, float* rss, int gw, int NGW, int lane) {
    for (int row = gw; row < MT; row += NGW) {
        const float* xr = row < MP ? xp + (size_t)row * DM : xs + (size_t)(row - MP) * DM;
        const int ci = row < MP ? 8 : ((row - MP) >> 12);
        const float* mrow = mod + (size_t)ci * 12288;
        const f32x4* x4 = (const f32x4*)xr + lane;
        f32x4 v[8]; float ss = 0.f;
#pragma unroll
        for (int j = 0; j < 8; ++j) { v[j] = x4[64 * j]; ss += (v[j].x * v[j].x + v[j].y * v[j].y) + (v[j].z * v[j].z + v[j].w * v[j].w); }
        ss = wave_sum(ss);
        if (lane == 0) rss[row] = ss;
        u32x2* o8 = (u32x2*)(XG + (size_t)row * DM) + lane;
#pragma unroll
        for (int j = 0; j < 8; ++j) {
            const f32x4 g = ((const f32x4*)gain)[64 * j + lane], sc = ((const f32x4*)(mrow + sc_off))[64 * j + lane];
            const f32x4 r = v[j] * g * (sc + 1.0f);
            u32x2 w; w.x = cvt_pk_bf16(r.x, r.y); w.y = cvt_pk_bf16(r.z, r.w); o8[64 * j] = w; }
    }
}
__device__ __forceinline__ void bias_mat(LAS unsigned char* lds, const bf16_t* Wt, int N, const float* shbase, float* bias, int gw, int NGW, int tid, int lane, int off = 0) {
    __syncthreads();
    for (int i = tid; i < 16 * 256; i += NTHREADS) {
        const int ci = i >> 8, ch = i & 255; u32x4 w = {0u, 0u, 0u, 0u};
        if (ci < 9) { const float* p = shbase + (size_t)ci * 12288 + ch * 8; const f32x4 a = *(const f32x4*)p, c = *(const f32x4*)(p + 4);
            w.x = cvt_pk_bf16(a.x, a.y); w.y = cvt_pk_bf16(a.z, a.w); w.z = cvt_pk_bf16(c.x, c.y); w.w = cvt_pk_bf16(c.z, c.w); }
        *(LAS u32x4*)(lds + ci * 4096 + 16 * (ch ^ ci)) = w; }
    __syncthreads();
    const int ci = lane & 15, q = lane >> 4;
    for (int t = (gw + NGW - off % NGW) % NGW; t < N / 16; t += NGW) {
        const bf16_t* wrow = Wt + (size_t)(16 * t + ci) * DM + 8 * q;
        f32x4 acc = {0.f, 0.f, 0.f, 0.f};
#pragma unroll 8
        for (int s_ = 0; s_ < 64; ++s_) {
            const bf16x8 bf = *(const bf16x8*)(wrow + 32 * s_);
            const bf16x8 af = *(const LAS bf16x8*)(lds + ci * 4096 + 16 * ((4 * s_ + q) ^ ci));
            acc = __builtin_amdgcn_mfma_f32_16x16x32_bf16(af, bf, acc, 0, 0, 0); }
#pragma unroll
        for (int r = 0; r < 4; ++r) { const int c = 4 * q + r; if (c < 9) bias[(size_t)c * N + 16 * t + ci] = acc[r]; }
    }
}

__device__ __forceinline__ unsigned img_off(unsigned row, unsigned ch) { return 256u * row + 16u * (ch ^ (((row & 3) << 2) | ((row >> 2) & 3))); }
__device__ __forceinline__ unsigned img_row_addr(unsigned lane, unsigned rb, unsigned s) { return img_off(32 * rb + (lane & 31), 2 * s + (lane >> 5)); }
__device__ __forceinline__ unsigned img_tr_addr(unsigned lane, unsigned c, unsigned ks, unsigned t) {
    const unsigned h = lane >> 5, blk = (lane >> 4) & 1, q = (lane & 15) >> 2, p = lane & 3;
    return img_off(16 * ks + 8 * h + 4 * t + q, 4 * c + 2 * blk + (p >> 1)) + 8 * (p & 1);
}
__device__ __forceinline__ unsigned img_row_addr16(unsigned lane, unsigned rb, unsigned s) { return img_off((lane & 15) + 16 * rb, 4 * s + (lane >> 4)); }
__device__ __forceinline__ s16x4 ds_tr_read(unsigned addr) { s16x4 r; asm volatile("ds_read_b64_tr_b16 %0, %1" : "=&v"(r) : "v"(addr) : "memory"); return r; }
__device__ __forceinline__ int crow32(int r, int hi) { return (r & 3) + 8 * (r >> 2) + 4 * hi; }
#define PK4X(P, BASE, OUT) do { unsigned a0_ = cvt_pk_bf16(P[BASE + 0], P[BASE + 1]), a1_ = cvt_pk_bf16(P[BASE + 2], P[BASE + 3]);   \
    unsigned b0_ = cvt_pk_bf16(P[BASE + 4], P[BASE + 5]), b1_ = cvt_pk_bf16(P[BASE + 6], P[BASE + 7]);                              \
    auto r0_ = __builtin_amdgcn_permlane32_swap(a0_, b0_, false, false); auto r1_ = __builtin_amdgcn_permlane32_swap(a1_, b1_, false, false); \
    u32x4 w_ = {r0_[0], r1_[0], r0_[1], r1_[1]}; OUT = *reinterpret_cast<bf16x8*>(&w_); } while (0)

template <bool SILU>
__device__ __forceinline__ void conv_inplace(bf16_t* buf, int ld, int col0, int ncols, const bf16_t* halo, const float* cw, const float* cb, int gtid, int gthreads) {
    const int ngrp = ncols / 8, nitems = 144 * ngrp;
    for (int it = gtid; it < nitems; it += gthreads) {
        const int pm = it / ngrp, cg = it % ngrp, c = cg * 8;
        const bool first = pm < 16 ? true : (((pm - 16) & 15) == 0), last = pm < 16 ? true : (((pm - 16) & 15) == 15);
        float w0[8], w1[8], w2[8], w3[8], bs[8];
#pragma unroll
        for (int e = 0; e < 8; ++e) { w0[e] = cw[c + e]; w1[e] = cw[ncols + c + e]; w2[e] = cw[2 * ncols + c + e]; w3[e] = cw[3 * ncols + c + e]; bs[e] = cb[c + e]; }
        bf16_t* base = buf + (size_t)pm * 256 * ld + col0 + c;
        const u32x4 zero = {0u, 0u, 0u, 0u};
        u32x4 rm1 = first ? zero : *(const u32x4*)(halo + ((size_t)(pm - 1) * 3 + 2) * ncols + c);
        u32x4 r0 = *(const u32x4*)(base), r1 = *(const u32x4*)(base + ld);
        const u32x4 n0 = last ? zero : *(const u32x4*)(halo + ((size_t)(pm + 1) * 3 + 0) * ncols + c);
        const u32x4 n1 = last ? zero : *(const u32x4*)(halo + ((size_t)(pm + 1) * 3 + 1) * ncols + c);
#define CV_UNPACK(v, f) do { f[0] = bf_lo(v.x); f[1] = bf_hi(v.x); f[2] = bf_lo(v.y); f[3] = bf_hi(v.y); f[4] = bf_lo(v.z); f[5] = bf_hi(v.z); f[6] = bf_lo(v.w); f[7] = bf_hi(v.w); } while (0)
        for (int t = 0; t < 256; t += 8) {
            u32x4 q[11];
            q[0] = rm1; q[1] = r0; q[2] = r1;
#pragma unroll
            for (int k = 0; k < 8; ++k) { const int rr = t + 2 + k; q[3 + k] = rr < 256 ? *(const u32x4*)(base + (size_t)rr * ld) : (rr == 256 ? n0 : n1); }
            asm volatile("" ::: "memory");
#pragma unroll
            for (int k = 0; k < 8; ++k) {
                float a[8], b[8], cc[8], d[8], o[8];
                CV_UNPACK(q[k], a); CV_UNPACK(q[k + 1], b); CV_UNPACK(q[k + 2], cc); CV_UNPACK(q[k + 3], d);
#pragma unroll
                for (int e = 0; e < 8; ++e) { float v = bs[e] + w0[e] * a[e] + w1[e] * b[e] + w2[e] * cc[e] + w3[e] * d[e]; o[e] = SILU ? silu_f(v) : v; }
                u32x4 w; w.x = cvt_pk_bf16(o[0], o[1]); w.y = cvt_pk_bf16(o[2], o[3]); w.z = cvt_pk_bf16(o[4], o[5]); w.w = cvt_pk_bf16(o[6], o[7]);
                *(u32x4*)(base + (size_t)(t + k) * ld) = w;
            }
            rm1 = q[8]; r0 = q[9]; r1 = q[10];
        }
#undef CV_UNPACK
    }
}

namespace ssd {
constexpr int OFF_B = 0  , OFF_X = 65536, OFF_S = 98304, OFF_SM = 132096;
constexpr int SM_CUM = 0, SM_ECUM = 128, SM_WST = 256, SM_DT = 384, SM_HEAD = 512, SM_TOT = 1024;
__device__ __forceinline__ void scan_unit(LAS unsigned char* lds, bf16_t* zx, const float* dtraw, bf16_t* Y, const float* dt_bias, const float* a_log, const float* d_skip, const float* nw, float* rss9,
                                          const float* s0  , float* sT  , int row_base, int nchunks, int hp, const int wv_) {
    const int tid = opaque_tid(wv_), lane = tid & 63, wid = __builtin_amdgcn_readfirstlane(tid >> 6), hd = wid >> 2, ib = hd ? 3 - (wid & 3) : (wid & 3), r32 = lane & 31, hi = lane >> 5;
    const int head = 2 * hp + hd, grp = hp >> 2;
    LAS float* sm = (LAS float*)(lds + OFF_SM);
    LAS float* smh = sm + hd * SM_HEAD;
    const float dsk = d_skip[head];
    const unsigned ldsb = (unsigned)(uintptr_t)lds;
    constexpr int SM_NW = 1280;
    __syncthreads();
    if (tid < 128) sm[SM_NW + tid] = nw[hp * 128 + tid];
    unsigned RA0, TA0, EA0;
    { const unsigned fl = ((r32 & 3) << 2) | ((r32 >> 2) & 3); RA0 = 256u * r32 + 16u * ((unsigned)hi ^ fl);
      const unsigned blk = (lane >> 4) & 1, q = (lane & 15) >> 2, p = lane & 3; const unsigned L1 = 4 * q + 2 * (blk ^ (unsigned)hi) + (p >> 1); TA0 = 256u * (8 * hi + q) + 16u * L1 + 8u * (p & 1);
      EA0 = 1024u * hi + 16u * (((unsigned)r32 >> 3) ^ (unsigned)hi) + 2u * (r32 & 7); }
#define FR_(r) (4 * ((r) & 3) + 2 * (((r) >> 2) & 1))
#define ROWC_(r) (256 * (((r) & 3) + 8 * ((r) >> 2)))
#define SSD_DMA_B(rowN, bufsel) do { _Pragma("unroll") for (int q_ = 0; q_ < 4; ++q_) { const int i_ = wid * 4 + q_; const int row_ = 4 * i_ + (lane_c >> 4); \
        const int ch_ = (lane_c & 15) ^ ((((lane_c >> 4) & 3) << 2) | (i_ & 3)); \
        __builtin_amdgcn_global_load_lds((const unsigned*)(zx + (size_t)((rowN) + row_) * SSD_ZX + 8192 + grp * 128 + ch_ * 8), (LAS unsigned*)(lds + OFF_B + (bufsel) * 32768 + 1024 * i_), 16, 0, 0); } } while (0)
#define SSD_LOAD_X(dst, rowN) do { _Pragma("unroll") for (int q_ = 0; q_ < 4; ++q_) { const int idx_ = tid_c + 512 * q_; dst[q_] = *(const u32x4*)(zx + (size_t)((rowN) + (idx_ >> 4)) * SSD_ZX + 4096 + hp * 128 + (idx_ & 15) * 8); } } while (0)
#define SSD_STORE_X(src) do { _Pragma("unroll") for (int q_ = 0; q_ < 4; ++q_) { const int idx_ = tid_c + 512 * q_; *(LAS u32x4*)(lds + OFF_X + img_off(idx_ >> 4, idx_ & 15)) = src[q_]; } } while (0)
#define SSD_LOAD_C(rowN) do { const bf16_t* cp_ = zx + (size_t)((rowN) + 32 * ib + r32) * SSD_ZX + 9216 + grp * 128 + 8 * hi; _Pragma("unroll") for (int s_ = 0; s_ < 8; ++s_) cf[s_] = *(const bf16x8*)(cp_ + 16 * s_); } while (0)
#define SSD_DT_ARRAYS(x0_, x1_) do { const int hh_ = 2 * hp + wid; const float An_ = -__expf(a_log[dir * 64 + hh_]); \
        const float d0_ = (x0_) > 20.f ? (x0_) : log1pf(__expf(x0_)), d1_ = (x1_) > 20.f ? (x1_) : log1pf(__expf(x1_)); const float a0_ = d0_ * An_, a1_ = d1_ * An_; \
        float P_ = a0_ + a1_; _Pragma("unroll") for (int o_ = 1; o_ < 64; o_ <<= 1) { const float t_ = __shfl_up(P_, o_); if (lane >= o_) P_ += t_; } \
        const float T_ = __shfl(P_, 63); float c0_ = P_ - a1_, c1_ = P_; if (dir) { c0_ = T_ - c0_ + a0_; c1_ = T_ - c1_ + a1_; } \
        LAS float* o_ = sm + wid * SM_HEAD; o_[SM_CUM + 2 * lane] = c0_; o_[SM_CUM + 2 * lane + 1] = c1_; o_[SM_ECUM + 2 * lane] = __expf(c0_); o_[SM_ECUM + 2 * lane + 1] = __expf(c1_); \
        o_[SM_WST + 2 * lane] = __expf(T_ - c0_) * d0_; o_[SM_WST + 2 * lane + 1] = __expf(T_ - c1_) * d1_; o_[SM_DT + 2 * lane] = __log2f(d0_) - c0_ * 1.4426950408889634f; o_[SM_DT + 2 * lane + 1] = __log2f(d1_) - c1_ * 1.4426950408889634f; \
        if (lane == 0) sm[SM_TOT + wid] = T_; } while (0)
#pragma unroll 1
    for (int dir = 0; dir < 2; ++dir) {
        f32x16 Sacc[2];
        bf16x8 cf[8];
        u32x4 xpre[4];
        float dtn0 = 0.f, dtn1 = 0.f;
        const int dtcol = dir * 64 + 2 * hp + (wid & 1);
        const float dtb = dt_bias[dtcol];
#pragma unroll
        for (int pb = 0; pb < 2; ++pb)
#pragma unroll
            for (int r = 0; r < 16; ++r) { const int p = 32 * pb + crow32(r, hi), n = 32 * ib + r32;
                Sacc[pb][r] = s0 ? s0[(((size_t)dir * 64 + head) * 64 + p) * 128 + n] : 0.f; }
        const int rowF = row_base + (dir ? nchunks - 1 : 0) * 128;
        __syncthreads();
        { int tid_c = tid; asm volatile("" : "+v"(tid_c)); const int lane_c = tid_c & 63; (void)lane_c;
        SSD_DMA_B(rowF, 0); SSD_LOAD_X(xpre, rowF); SSD_LOAD_C(rowF);
        if (wid < 2) { dtn0 = dtraw[(size_t)(rowF + 2 * lane) * 128 + dtcol] + dtb; dtn1 = dtraw[(size_t)(rowF + 2 * lane + 1) * 128 + dtcol] + dtb; }
        { const unsigned SB = ldsb + OFF_S + hd * 16384 + (EA0 ^ (64u * ib));
#pragma unroll
          for (int pb = 0; pb < 2; ++pb)
#pragma unroll
            for (int r = 0; r < 16; ++r) *(LAS bf16_t*)(uintptr_t)((SB ^ (16u * FR_(r))) + 8192 * pb + ROWC_(r)) = (bf16_t)(cvt_pk_bf16(Sacc[pb][r], 0.f) & 0xffffu); }
        SSD_STORE_X(xpre); }
        if (wid < 2) SSD_DT_ARRAYS(dtn0, dtn1);
        VM_WAIT();
        __syncthreads();
#pragma unroll 1
        for (int cc = 0; cc < nchunks; ++cc) {
            const int chunk = dir ? nchunks - 1 - cc : cc;
            const int row0 = row_base + chunk * 128;
            const int rowN = row_base + (dir ? chunk - 1 : chunk + 1) * 128;
            const bool has_next = cc + 1 < nchunks;
            const int bsel = cc & 1;
            unsigned RA = RA0, TA = TA0, EA = EA0; asm volatile("" : "+v"(RA), "+v"(TA), "+v"(EA));
            int tid_c = tid; asm volatile("" : "+v"(tid_c)); const int lane_c = tid_c & 63;
            const unsigned yvoff = (unsigned)(r32 * SSD_DI + 64 * hd + 4 * hi) * 2u;
            const char* ybase = (const char*)Y + ((size_t)(row0 + 32 * ib) * SSD_DI + hp * 128) * 2;
            const unsigned BI = ldsb + OFF_B + bsel * 32768;
            f32x16 Yacc[2];
            const float eci = smh[SM_ECUM + 32 * ib + r32];
#pragma unroll
            for (int pb = 0; pb < 2; ++pb) { f32x16 a3 = {};
                {
#define SSD_SF(s_) (*(const LAS bf16x8*)(uintptr_t)(ldsb + OFF_S + hd * 16384 + ((RA ^ (32u * (s_))) + 8192u * pb)))
                    bf16x8 f0 = SSD_SF(0), f1 = SSD_SF(1); __builtin_amdgcn_sched_barrier(0);
                    a3 = __builtin_amdgcn_mfma_f32_32x32x16_bf16(f0, cf[0], a3, 0, 0, 0); f0 = SSD_SF(2); __builtin_amdgcn_sched_barrier(0);
                    a3 = __builtin_amdgcn_mfma_f32_32x32x16_bf16(f1, cf[1], a3, 0, 0, 0); f1 = SSD_SF(3); __builtin_amdgcn_sched_barrier(0);
                    a3 = __builtin_amdgcn_mfma_f32_32x32x16_bf16(f0, cf[2], a3, 0, 0, 0); f0 = SSD_SF(4); __builtin_amdgcn_sched_barrier(0);
                    a3 = __builtin_amdgcn_mfma_f32_32x32x16_bf16(f1, cf[3], a3, 0, 0, 0); f1 = SSD_SF(5); __builtin_amdgcn_sched_barrier(0);
                    a3 = __builtin_amdgcn_mfma_f32_32x32x16_bf16(f0, cf[4], a3, 0, 0, 0); f0 = SSD_SF(6); __builtin_amdgcn_sched_barrier(0);
                    a3 = __builtin_amdgcn_mfma_f32_32x32x16_bf16(f1, cf[5], a3, 0, 0, 0); f1 = SSD_SF(7); __builtin_amdgcn_sched_barrier(0);
                    a3 = __builtin_amdgcn_mfma_f32_32x32x16_bf16(f0, cf[6], a3, 0, 0, 0); __builtin_amdgcn_sched_barrier(0);
                    a3 = __builtin_amdgcn_mfma_f32_32x32x16_bf16(f1, cf[7], a3, 0, 0, 0); __builtin_amdgcn_sched_barrier(0);
#undef SSD_SF
                }
#pragma unroll
                for (int r = 0; r < 16; ++r) a3[r] *= eci;
                Yacc[pb] = a3; }
            if (has_next) { SSD_DMA_B(rowN, bsel ^ 1); SSD_LOAD_X(xpre, rowN);
                if (wid < 2) { dtn0 = dtraw[(size_t)(rowN + 2 * lane) * 128 + dtcol]; dtn1 = dtraw[(size_t)(rowN + 2 * lane + 1) * 128 + dtcol]; } }
            const float ci2 = smh[SM_CUM + 32 * ib + r32] * 1.4426950408889634f;
            const int i_loc = 32 * ib + r32;
            const unsigned XT = ldsb + OFF_X + (TA ^ (128u * hd));
#pragma unroll 1
            for (int jj = 0; jj < 4; ++jj) {
                const int jb = dir ? (3 - jj) : jj;
                const bool active = dir ? (jb >= ib) : (jb <= ib);
                if (active) {
                    f32x16 sc = {};
                    unsigned RAj = RA; asm volatile("" : "+v"(RAj));
#define SSD_BF(s_) (*(const LAS bf16x8*)(uintptr_t)(BI + ((RAj ^ (32u * (s_))) + 8192u * jb)))
#define SSD_SB() __builtin_amdgcn_sched_barrier(0)
                    {
                        bf16x8 f0 = SSD_BF(0), f1 = SSD_BF(1); SSD_SB();
                        sc = __builtin_amdgcn_mfma_f32_32x32x16_bf16(f0, cf[0], sc, 0, 0, 0); f0 = SSD_BF(2); SSD_SB();
                        sc = __builtin_amdgcn_mfma_f32_32x32x16_bf16(f1, cf[1], sc, 0, 0, 0); f1 = SSD_BF(3); SSD_SB();
                        sc = __builtin_amdgcn_mfma_f32_32x32x16_bf16(f0, cf[2], sc, 0, 0, 0); f0 = SSD_BF(4); SSD_SB();
                        sc = __builtin_amdgcn_mfma_f32_32x32x16_bf16(f1, cf[3], sc, 0, 0, 0); f1 = SSD_BF(5); SSD_SB();
                        sc = __builtin_amdgcn_mfma_f32_32x32x16_bf16(f0, cf[4], sc, 0, 0, 0); f0 = SSD_BF(6); SSD_SB();
                        sc = __builtin_amdgcn_mfma_f32_32x32x16_bf16(f1, cf[5], sc, 0, 0, 0); f1 = SSD_BF(7); SSD_SB();
                        sc = __builtin_amdgcn_mfma_f32_32x32x16_bf16(f0, cf[6], sc, 0, 0, 0); SSD_SB();
                        sc = __builtin_amdgcn_mfma_f32_32x32x16_bf16(f1, cf[7], sc, 0, 0, 0); SSD_SB(); }
#undef SSD_BF
                    const unsigned xb = XT + 8192u * jb;
                    s16x4 xl0[2], xh0[2], xl1[2], xh1[2];
                    xl0[0] = ds_tr_read(xb); xh0[0] = ds_tr_read((xb ^ 16u) + 1024u); xl1[0] = ds_tr_read(xb + 4096u); xh1[0] = ds_tr_read((xb ^ 16u) + 4096u + 1024u);
#pragma unroll
                    for (int rh = 0; rh < 2; ++rh) {
                        float qj[8];
#pragma unroll
                        for (int r = 0; r < 8; ++r) qj[r] = smh[SM_DT + 32 * jb + crow32(8 * rh + r, hi)];
                        SSD_SB();
#pragma unroll
                        for (int r = 0; r < 8; ++r) { const int j = 32 * jb + crow32(8 * rh + r, hi); const bool ok = dir ? (j >= i_loc) : (j <= i_loc);
                            const float wgt = __builtin_amdgcn_exp2f(ci2 + qj[r]) * sc[8 * rh + r];
                            sc[8 * rh + r] = ok ? wgt : 0.f; }
                        SSD_SB();
                    }
                    bf16x8 pa0, pa1; PK4X(sc, 0, pa0); PK4X(sc, 8, pa1);
                    xl0[1] = ds_tr_read((xb ^ 64u)); xh0[1] = ds_tr_read((xb ^ (64u + 16u)) + 1024u); xl1[1] = ds_tr_read((xb ^ 64u) + 4096u); xh1[1] = ds_tr_read((xb ^ (64u + 16u)) + 4096u + 1024u);
                    asm volatile("s_waitcnt lgkmcnt(4)" ::: "memory"); SSD_SB();
#pragma unroll
                    for (int pb = 0; pb < 2; ++pb) {
                        if (pb == 1) { asm volatile("s_waitcnt lgkmcnt(0)" ::: "memory"); SSD_SB(); }
                        Yacc[pb] = __builtin_amdgcn_mfma_f32_32x32x16_bf16((bf16x8){xl0[pb][0], xl0[pb][1], xl0[pb][2], xl0[pb][3], xh0[pb][0], xh0[pb][1], xh0[pb][2], xh0[pb][3]}, pa0, Yacc[pb], 0, 0, 0);
                        Yacc[pb] = __builtin_amdgcn_mfma_f32_32x32x16_bf16((bf16x8){xl1[pb][0], xl1[pb][1], xl1[pb][2], xl1[pb][3], xh1[pb][0], xh1[pb][1], xh1[pb][2], xh1[pb][3]}, pa1, Yacc[pb], 0, 0, 0); }
                }
            }
            if (has_next) SSD_LOAD_C(rowN);
            const unsigned zvoff = (unsigned)(r32 * SSD_ZX + 64 * hd + 4 * hi) * 2u;
            char* zbase = (char*)zx + ((size_t)(row0 + 32 * ib) * SSD_ZX + hp * 128) * 2;
            u32x2 zpre[2][4], prev[2][4];
            if (dir == 1) {
#pragma unroll
                for (int pb = 0; pb < 2; ++pb)
#pragma unroll
                    for (int g = 0; g < 4; ++g) { zpre[pb][g] = *(const u32x2*)(zbase + zvoff + (32 * pb + 8 * g) * 2); prev[pb][g] = *(const u32x2*)(ybase + yvoff + (32 * pb + 8 * g) * 2); }
            }
            {
                const float dec = __expf(sm[SM_TOT + hd]);
#pragma unroll
                for (int pb = 0; pb < 2; ++pb)
#pragma unroll
                    for (int r = 0; r < 16; ++r) Sacc[pb][r] *= dec;
                const unsigned BT = BI + (TA ^ (64u * ib));
#define P4_READ(ks_) do { bl = ds_tr_read(BT + 4096u * (ks_)); bh = ds_tr_read((BT ^ 16u) + 4096u * (ks_) + 1024u); x0l = ds_tr_read(XT + 4096u * (ks_)); x0h = ds_tr_read((XT ^ 16u) + 4096u * (ks_) + 1024u); \
                    x1l = ds_tr_read((XT ^ 64u) + 4096u * (ks_)); x1h = ds_tr_read((XT ^ (64u + 16u)) + 4096u * (ks_) + 1024u); } while (0)
                s16x4 bl, bh, x0l, x0h, x1l, x1h;
                P4_READ(0);
#pragma unroll 1
                for (int ks = 0; ks < 8; ++ks) {
                    float wj[8];
#pragma unroll
                    for (int e = 0; e < 8; ++e) wj[e] = smh[SM_WST + 16 * ks + 8 * hi + e];
                    asm volatile("s_waitcnt lgkmcnt(0)" ::: "memory"); __builtin_amdgcn_sched_barrier(0);
                    float fb[8];
#pragma unroll
                    for (int e = 0; e < 4; ++e) { fb[e] = __uint_as_float(((unsigned)(unsigned short)bl[e]) << 16) * wj[e]; fb[4 + e] = __uint_as_float(((unsigned)(unsigned short)bh[e]) << 16) * wj[4 + e]; }
                    u32x4 wb = {cvt_pk_bf16(fb[0], fb[1]), cvt_pk_bf16(fb[2], fb[3]), cvt_pk_bf16(fb[4], fb[5]), cvt_pk_bf16(fb[6], fb[7])};
                    const bf16x8 a0 = {x0l[0], x0l[1], x0l[2], x0l[3], x0h[0], x0h[1], x0h[2], x0h[3]}, a1 = {x1l[0], x1l[1], x1l[2], x1l[3], x1h[0], x1h[1], x1h[2], x1h[3]};
                    __builtin_amdgcn_sched_barrier(0);
                    Sacc[0] = __builtin_amdgcn_mfma_f32_32x32x16_bf16(a0, *reinterpret_cast<bf16x8*>(&wb), Sacc[0], 0, 0, 0);
                    Sacc[1] = __builtin_amdgcn_mfma_f32_32x32x16_bf16(a1, *reinterpret_cast<bf16x8*>(&wb), Sacc[1], 0, 0, 0);
                    __builtin_amdgcn_sched_barrier(0);
                    if (ks + 1 < 8) P4_READ(ks + 1);
                }
#undef P4_READ
            }
            {
                const unsigned XE = ldsb + OFF_X + 8192u * ib + ((256u * r32 + 16u * (((r32 & 3) << 2) | ((r32 >> 2) & 3)) + 8u * hi) ^ (128u * hd));
                if (dir == 0) {
#pragma unroll
                    for (int pb = 0; pb < 2; ++pb)
#pragma unroll
                        for (int g = 0; g < 4; ++g) {
                            const u32x2 xr = *(const LAS u32x2*)(uintptr_t)(XE ^ (16u * (4 * pb + g)));
                            const float v0 = Yacc[pb][4 * g] + dsk * bf_lo(xr.x), v1 = Yacc[pb][4 * g + 1] + dsk * bf_hi(xr.x), v2 = Yacc[pb][4 * g + 2] + dsk * bf_lo(xr.y), v3 = Yacc[pb][4 * g + 3] + dsk * bf_hi(xr.y);
                            u32x2 w; w.x = cvt_pk_bf16(v0, v1); w.y = cvt_pk_bf16(v2, v3);
                            *(u32x2*)((char*)ybase + yvoff + (32 * pb + 8 * g) * 2) = w; }
                } else {
                    asm volatile("s_waitcnt vmcnt(0)" ::: "memory");
                    float ssq = 0.f;
#pragma unroll
                    for (int pb = 0; pb < 2; ++pb)
#pragma unroll
                        for (int g = 0; g < 4; ++g) {
                            const u32x2 zq = zpre[pb][g], pq = prev[pb][g];
                            const float v0 = Yacc[pb][4 * g] + bf_lo(pq.x), v1 = Yacc[pb][4 * g + 1] + bf_hi(pq.x), v2 = Yacc[pb][4 * g + 2] + bf_lo(pq.y), v3 = Yacc[pb][4 * g + 3] + bf_hi(pq.y);
                            const float gt0 = v0 * silu_f(bf_lo(zq.x)), gt1 = v1 * silu_f(bf_hi(zq.x)), gt2 = v2 * silu_f(bf_lo(zq.y)), gt3 = v3 * silu_f(bf_hi(zq.y));
                            ssq += (gt0 * gt0 + gt1 * gt1) + (gt2 * gt2 + gt3 * gt3);
                            const f32x4 w4 = *(const LAS f32x4*)(sm + SM_NW + 64 * hd + 32 * pb + 8 * g + 4 * hi);
                            u32x2 w; w.x = cvt_pk_bf16(gt0 * w4.x, gt1 * w4.y); w.y = cvt_pk_bf16(gt2 * w4.z, gt3 * w4.w);
                            *(u32x2*)(zbase + zvoff + (32 * pb + 8 * g) * 2) = w; }
                    ssq += __shfl_xor(ssq, 32); if (hi == 0) atomicAdd(rss9 + row0 + 32 * ib + r32, rintf(ssq * 16.f) * 0.0625f);
                }
            }
            LBAR();
            { const unsigned SB = ldsb + OFF_S + hd * 16384 + (EA ^ (64u * ib));
#pragma unroll
              for (int pb = 0; pb < 2; ++pb)
#pragma unroll
                for (int r = 0; r < 16; ++r) *(LAS bf16_t*)(uintptr_t)((SB ^ (16u * FR_(r))) + 8192 * pb + ROWC_(r)) = (bf16_t)(cvt_pk_bf16(Sacc[pb][r], 0.f) & 0xffffu); }
            if (has_next) { SSD_STORE_X(xpre); if (wid < 2) SSD_DT_ARRAYS(dtn0 + dtb, dtn1 + dtb); }
            asm volatile("s_waitcnt vmcnt(9)" ::: "memory");
            LBAR();
        }
        if (sT) {
#pragma unroll
            for (int pb = 0; pb < 2; ++pb)
#pragma unroll
                for (int r = 0; r < 16; ++r) { const int p = 32 * pb + crow32(r, hi), n = 32 * ib + r32;
                    sT[(((size_t)dir * 64 + head) * 64 + p) * 128 + n] = Sacc[pb][r]; }
        }
    }
#undef FR_
#undef ROWC_
#undef SSD_SB
#undef SSD_DMA_B
#undef SSD_LOAD_X
#undef SSD_STORE_X
#undef SSD_LOAD_C
#undef SSD_DT_ARRAYS
    VM_WAIT();
    __syncthreads();
}
}

namespace lru {
constexpr int OFF_R = 0, OFF_W = 32768, OFF_A = 65536, OFF_U = 98304, OFF_AG = 132096  , OFF_UG = OFF_AG + 2048, OFF_CAR = OFF_UG + 2048  ;
__device__ __forceinline__ float sigmoid_f(float x) { return __builtin_amdgcn_rcpf(1.0f + __expf(-x)); }
__device__ __forceinline__ float gelu_tanh(float x) { const float u = 0.7978845608028654f * (x + 0.044715f * x * x * x); const float t = 1.0f - 2.0f * __builtin_amdgcn_rcpf(1.0f + __expf(2.0f * u)); return 0.5f * x * (1.0f + t); }
__device__ __forceinline__ void scan_unit(LAS unsigned char* lds, const bf16_t* gr, bf16_t* YL, const bf16_t* wg, const float* b_a, const float* b_i, const float* a_param,
                                          const float* h0  , float* hT  , int row_base, int ntiles, int nblk, int vh, const int wv_) {
    const int tid = opaque_tid(wv_), lane = tid & 63, wid = __builtin_amdgcn_readfirstlane(tid >> 6);
    const int ch0 = nblk * 128 + vh * 64;
    const int sv = lane, seg = wid;
    const unsigned lvoff = (unsigned)sv * 2u;
#pragma unroll 1
    for (int dir = 0; dir < 2; ++dir) {
        __syncthreads();
#pragma unroll
        for (int q = 0; q < 4; ++q) { const int idx = tid + 512 * q, im = idx >> 10, rem = idx & 1023, row = rem >> 4, ch = rem & 15;
            const u32x4 v = *(const u32x4*)(wg + ((size_t)((dir * 2 + im) * 16 + nblk) * 128 + vh * 64 + row) * 128 + ch * 8);
            *(LAS u32x4*)(lds + OFF_W + im * 16384 + img_off(row, ch)) = v; }
        float ba[4], bi[4], sp[4];
#pragma unroll
        for (int k = 0; k < 4; ++k) { const int ch = ch0 + k * 16 + (lane & 15);
            ba[k] = b_a[dir * 2048 + ch]; bi[k] = b_i[dir * 2048 + ch]; const float ap = -a_param[dir * 2048 + ch]; sp[k] = -8.0f * (ap > 20.f ? ap : log1pf(__expf(ap))); }
        if (tid < 64) *(LAS float*)(lds + OFF_CAR + tid * 4) = h0 ? h0[dir * 2048 + ch0 + tid] : 0.f;
        u32x4 pre[4];
        { const int tile0 = dir ? ntiles - 1 : 0; const int r0 = row_base + tile0 * 128;
#pragma unroll
          for (int q = 0; q < 4; ++q) { const int idx = tid + 512 * q, row = idx >> 4, ch = idx & 15; pre[q] = *(const u32x4*)(gr + (size_t)(r0 + row) * 4096 + 2048 + nblk * 128 + ch * 8); } }
#pragma unroll 1
        for (int tt = 0; tt < ntiles; ++tt) {
            const int tile = dir ? ntiles - 1 - tt : tt;
            const int row0 = row_base + tile * 128;
#pragma unroll
            for (int q = 0; q < 4; ++q) { const int idx = tid + 512 * q, row = idx >> 4, ch = idx & 15; *(LAS u32x4*)(lds + OFF_R + img_off(row, ch)) = pre[q]; }
            if (tt + 1 < ntiles) { const int r1 = row_base + (dir ? tile - 1 : tile + 1) * 128;
#pragma unroll
                for (int q = 0; q < 4; ++q) { const int idx = tid + 512 * q, row = idx >> 4, ch = idx & 15; pre[q] = *(const u32x4*)(gr + (size_t)(r1 + row) * 4096 + 2048 + nblk * 128 + ch * 8); } }
            unsigned pv[16], gv[16];
            if (dir == 1) {
#pragma unroll
                for (int k = 0; k < 16; ++k) { const int t = wid * 16 + 15 - k;
                    pv[k] = *(const bf16_t*)((const char*)YL + ((size_t)(row0 + t) * 2048 + ch0) * 2 + lvoff); gv[k] = *(const bf16_t*)((const char*)gr + ((size_t)(row0 + t) * 4096 + ch0) * 2 + lvoff); }
            }
            LBAR();
            {
                f32x4 accA[4] = {}, accI[4] = {};
#pragma unroll
                for (int s_ = 0; s_ < 4; ++s_) { const bf16x8 af = *(const LAS bf16x8*)(lds + OFF_R + img_row_addr16(lane, wid, s_));
#pragma unroll
                    for (int k = 0; k < 4; ++k) {
                        const bf16x8 wa = *(const LAS bf16x8*)(lds + OFF_W + img_row_addr16(lane, k, s_));
                        const bf16x8 wi = *(const LAS bf16x8*)(lds + OFF_W + 16384 + img_row_addr16(lane, k, s_));
                        accA[k] = __builtin_amdgcn_mfma_f32_16x16x32_bf16(af, wa, accA[k], 0, 0, 0);
                        accI[k] = __builtin_amdgcn_mfma_f32_16x16x32_bf16(af, wi, accI[k], 0, 0, 0); } }
#pragma unroll
                for (int k = 0; k < 4; ++k)
#pragma unroll
                    for (int r = 0; r < 4; ++r) { const int t = 16 * wid + 4 * (lane >> 4) + r, v = k * 16 + (lane & 15), wcol = vh * 64 + v;
                        const float ea = fminf(__expf(-(accA[k][r] + ba[k])), 1e18f), ei = fminf(__expf(-(accI[k][r] + bi[k])), 1e18f);
                        const float rr_ = __builtin_amdgcn_rcpf((1.0f + ea) * (1.0f + ei)), rg = rr_ * (1.0f + ei), ig = rr_ * (1.0f + ea);
                        const float a = __expf(rg * sp[k]);
                        const float rec = __uint_as_float(((unsigned)*(const LAS bf16_t*)(lds + OFF_R + img_off(t, wcol >> 3) + (wcol & 7) * 2)) << 16);
                        const float u = __builtin_amdgcn_sqrtf(fmaxf(1.0f - a * a, 0.f)) * ig * rec;
                        *(LAS f32x2*)(lds + OFF_A + (t * 64 + v) * 8) = (f32x2){a, u}; }
            }
            LBAR();
            {
                float a16[16], u16[16];
#pragma unroll
                for (int k = 0; k < 16; ++k) { const int t = seg * 16 + (dir ? 15 - k : k); const f32x2 au = *(const LAS f32x2*)(lds + OFF_A + (t * 64 + sv) * 8); a16[k] = au.x; u16[k] = au.y; }
                float Ap = 1.f, Up = 0.f;
#pragma unroll
                for (int k = 0; k < 16; ++k) { Up = a16[k] * Up + u16[k]; Ap *= a16[k]; }
                *(LAS float*)(lds + OFF_AG + (seg * 64 + sv) * 4) = Ap; *(LAS float*)(lds + OFF_UG + (seg * 64 + sv) * 4) = Up;
                LBAR();
                float h = *(const LAS float*)(lds + OFF_CAR + sv * 4);
                float ag[8], ug[8];
#pragma unroll
                for (int s2 = 0; s2 < 8; ++s2) { ag[s2] = *(const LAS float*)(lds + OFF_AG + (s2 * 64 + sv) * 4); ug[s2] = *(const LAS float*)(lds + OFF_UG + (s2 * 64 + sv) * 4); }
#pragma unroll
                for (int s2 = 0; s2 < 8; ++s2) { const int sg = dir ? 7 - s2 : s2; const bool before = dir ? (sg > seg) : (sg < seg);
                    if (before) h = ag[sg] * h + ug[sg]; }
                LBAR();
#pragma unroll
                for (int k = 0; k < 16; ++k) { const int t = wid * 16 + (dir ? 15 - k : k);
                    h = a16[k] * h + u16[k];
                    bf16_t* yp = (bf16_t*)((char*)YL + ((size_t)(row0 + t) * 2048 + ch0) * 2 + lvoff);
                    if (dir == 0) *yp = (bf16_t)(cvt_pk_bf16(h, 0.f) & 0xffffu);
                    else { const float hf = __uint_as_float(pv[k] << 16);
                        const float gt = __uint_as_float(gv[k] << 16);
                        *yp = (bf16_t)(cvt_pk_bf16((hf + h) * gelu_tanh(gt), 0.f) & 0xffffu); } }
                if (seg == (dir ? 0 : 7)) *(LAS float*)(lds + OFF_CAR + sv * 4) = h;
            }
            LBAR();
        }
        if (hT && tid < 64) hT[dir * 2048 + ch0 + tid] = *(const LAS float*)(lds + OFF_CAR + tid * 4);
    }
    VM_WAIT();
    __syncthreads();
}
}

struct Args { const float* in[36]; float* out; unsigned char* ws; int ph_lo, ph_hi; };
enum { I_XP = 0, I_XS, I_CK, I_CV, I_SSM, I_LRU, I_C, I_CCTX, I_ADAW, I_ADAB, I_NMIX, I_NFFN, I_WQKV, I_QN, I_KN, I_WO,
       I_SWIN, I_SCW, I_SCB, I_SDTB, I_SALOG, I_SD, I_SNORM, I_SWOUT, I_LWIN, I_LCW, I_LCB, I_LWA, I_LBA, I_LWI, I_LBI, I_LAP, I_LWOUT, I_FWIN, I_FWOUT, I_FNORM };

constexpr int PH_FINAL = 65, PH_END = 66;
typedef const __attribute__((address_space(4))) Args* ArgsP;
__device__ __forceinline__ ArgsP args_ptr() {
    unsigned long long p = (unsigned long long)(const __attribute__((address_space(4))) void*)__builtin_amdgcn_kernarg_segment_ptr();
    asm volatile("" : "+s"(p));
    return (ArgsP)p;
}

extern __shared__ __attribute__((aligned(16))) unsigned char lds_raw[];
#define PHASE_BEGIN() \
    int bx = blockIdx.x, G = gridDim.x; asm volatile("" : "+s"(bx), "+s"(G)); const int NGW = G * NWAVES; (void)NGW; \
    ArgsP A_ = args_ptr(); unsigned char* ws = A_->ws; float* out = A_->out; \
    unsigned ldsb_ = (unsigned)(uintptr_t)lds_raw; asm volatile("" : "+s"(ldsb_)); LAS unsigned char* lds = (LAS unsigned char*)(uintptr_t)ldsb_; \
    float* MOD = (float*)(ws + WS_MOD); bf16_t* H = (bf16_t*)(ws + WS_H); \
    (void)out; (void)lds; (void)MOD; (void)H
#define PHASE_IDS() const int tid = opaque_tid(wv_), lane = tid & 63, wave = __builtin_amdgcn_readfirstlane(tid >> 6), gw = bx * NWAVES + wave; (void)tid; (void)lane; (void)wave; (void)gw
#if MK_SINGLE
#define GRID_BAR() do { XcdBarrier b_ = bar; unsigned long long p_ = (unsigned long long)b_.bar; unsigned x_ = b_.x; asm volatile("" : "+s"(p_), "+s"(x_)); b_.bar = (unsigned*)p_; b_.x = x_; xcd_barrier(b_); } while (0)
#else
#define GRID_BAR() do { } while (0)
#endif
#define IN(k) (lo <= (k) && (k) < hi)
#define SEAM(k) do { if (IN(k) && IN((k) + 1)) GRID_BAR(); } while (0)
#define AIN(i) (A_->in[i])
#define LAYER_VALS() \
    const float* modL = MOD + (size_t)L * 9 * 12288; \
    const float* xin_p = AIN(I_XP); const float* xin_s = AIN(I_XS); bf16_t* X16 = (bf16_t*)(ws + WS_X16); (void)X16; \
    float* RSS = (float*)(ws + WS_RSS); float* BIAS = (float*)(ws + WS_BIAS); bf16_t* XG = H; \
    (void)modL; (void)xin_p; (void)xin_s; (void)RSS; (void)BIAS; (void)XG

template <int L> __device__ __forceinline__ void layer_phases(const int lo, const int hi, const XcdBarrier& bar, const int wv_) {

    constexpr int base = 1 + 16 * L, kind = L % 3, jm = L / 3;
        if (L == 0) {
            if (IN(base + 0) && EN(1)) {
                PHASE_BEGIN(); PHASE_IDS(); LAYER_VALS();
                _Pragma("unroll 1") for (int rep_ = 0; rep_ < REP_NORM; ++rep_) {
                const int gwi = wave * G + bx;
                bias_mat(lds, (const bf16_t*)(ws + W_QKV), NQKV, MOD + (size_t)0 * 9 * 12288, BIAS + BO_QKV, gwi, NGW, tid, lane, 0);
                bias_mat(lds, (const bf16_t*)(ws + W_QKV + W_QKV_SZ), NQKV, MOD + (size_t)3 * 9 * 12288, BIAS + BO_QKV + 9 * NQKV, gwi, NGW, tid, lane, 192);
                bias_mat(lds, (const bf16_t*)(ws + W_SSDIN), SSD_NPAD, MOD + (size_t)1 * 9 * 12288, BIAS + BO_SSD, gwi, NGW, tid, lane, 384);
                bias_mat(lds, (const bf16_t*)(ws + W_LRUIN), 4096, MOD + (size_t)2 * 9 * 12288, BIAS + BO_LRU, gwi, NGW, tid, lane, 1040);
                _Pragma("unroll 1") for (int l = 0; l < 4; ++l)
                    bias_mat(lds, (const bf16_t*)(ws + W_FFNIN + l * W_FFNIN_SZ), NFFN, MOD + (size_t)l * 9 * 12288 + 3 * 2048, BIAS + BO_FFN + l * BO_FFN_SZ, gwi, NGW, tid, lane, 1296 + l * 704);
                { float* GM = (float*)(ws + WS_GM);
                  for (int i = bx * NTHREADS + tid; i < 4 * 2 * 9 * 2048; i += G * NTHREADS) { const int k = i & 2047, ci2 = (i >> 11) % 9, sl = (i >> 11) / 9, l = sl >> 1, sb = sl & 1;
                      float gm = (sb ? AIN(I_NFFN) : AIN(I_NMIX))[l * DM + k] * (1.0f + MOD[((size_t)l * 9 + ci2) * 12288 + (sb ? 4 : 1) * 2048 + k]);
                      if (!(fabsf(gm) >= 9.5367431640625e-07f)) gm = copysignf(9.5367431640625e-07f, gm);
                      GM[i] = gm; ((float*)(ws + WS_RGM))[i] = 1.0f / gm; } }
                xg_init_pass(xin_p, xin_s, AIN(I_NMIX), modL, 2048, XG, RSS, gw, NGW, lane);
                __syncthreads();
                }
            }
            SEAM(base + 0);
        }
        if (kind == 0) {
#define ATT_BUFS() bf16_t* QKV = (bf16_t*)(ws + B_QKV); bf16_t* OB = (bf16_t*)(ws + B_O); bf16_t* KS = (bf16_t*)(ws + B_KS); bf16_t* VS = (bf16_t*)(ws + B_VS); \
            bf16_t* KP = (bf16_t*)(ws + B_KP); bf16_t* VP = (bf16_t*)(ws + B_VP); (void)QKV; (void)OB; (void)KS; (void)VS; (void)KP; (void)VP
            if (IN(base + 1) && EN(2)) {
                PHASE_BEGIN(); ATT_BUFS(); LAYER_VALS();
                pg8::Gemm g{XG, (const bf16_t*)(ws + W_QKV + jm * W_QKV_SZ), MT, NQKV, DM, DM}; pg8::StaticOrder S; S.init(MT, NQKV, G, bx);
                pg8::EpiBf16 E{QKV, NQKV, nullptr, 0, 0, pg8::RowMod{RSS + (size_t)(2 * L) * MT, BIAS + BO_QKV + jm * 9 * NQKV, NQKV}};
                pg8::gemm_phase<pg8::EpiBf16, pg8::StaticOrder, true, true>(lds, g, S, E, wv_);
#if REP_QKV > 1
                pg8::gemm_phase<pg8::EpiBf16, pg8::StaticOrder, true, true>(lds, g, S, E, wv_);
#endif
            }
            SEAM(base + 1);
            if (IN(base + 2) && EN(3)) {
                PHASE_BEGIN(); PHASE_IDS(); ATT_BUFS();
                const float* kn = AIN(I_KN) + jm * 128;
                const int grp = lane >> 4, sub = lane & 15;
                float kw[8];
#pragma unroll
                for (int e = 0; e < 8; ++e) kw[e] = kn[sub * 8 + e];
                const f32x2* rope = (const f32x2*)(ws + WS_ROPE);
                constexpr int RB = 3;
                for (int row0 = gw; row0 < MT; row0 += RB * NGW) {
                    u32x4 rawk[RB], rawv[RB]; f32x4 rpf[RB][4];
#pragma unroll
                    for (int j = 0; j < RB; ++j) { const int row = row0 + j * NGW; if (row < MT) {
                        const bool samp = row >= MP; const int t = samp ? ((row - MP) & 4095) : (row & 255);
                        const bf16_t* qrow = QKV + (size_t)row * NQKV;
                        rawk[j] = *(const u32x4*)(qrow + 2048 + grp * 128 + sub * 8); if (!samp) rawv[j] = *(const u32x4*)(qrow + 2560 + lane * 8);
                        const int i0 = 8 * (sub & 7); const int pos = (i0 < 32) ? (t >> 6) : (t & 63); const f32x4* rp = (const f32x4*)(rope + pos * 32 + (i0 & 31));
#pragma unroll
                        for (int q4 = 0; q4 < 4; ++q4) rpf[j][q4] = rp[q4]; } }
                    asm volatile("" ::: "memory");
#pragma unroll
                    for (int j = 0; j < RB; ++j) { const int row = row0 + j * NGW; if (row < MT) {
                        const bool samp = row >= MP;
                        const int b = samp ? ((row - MP) >> 12) : (row >> 8), t = samp ? ((row - MP) & 4095) : (row & 255);
                        {
                            const u32x4 raw = rawk[j];
                            float v[8] = {bf_lo(raw.x), bf_hi(raw.x), bf_lo(raw.y), bf_hi(raw.y), bf_lo(raw.z), bf_hi(raw.z), bf_lo(raw.w), bf_hi(raw.w)};
                            float ss = 0.f;
#pragma unroll
                            for (int e = 0; e < 8; ++e) ss += v[e] * v[e];
                            ss += __shfl_xor(ss, 1); ss += __shfl_xor(ss, 2); ss += __shfl_xor(ss, 4); ss += __shfl_xor(ss, 8);
                            const float rstd = 1.0f / sqrtf(ss * (1.0f / 128.0f) + EPS);
#pragma unroll
                            for (int e = 0; e < 8; ++e) v[e] = v[e] * rstd * kw[e];
                            float r[8];
                            if (!samp) {
                                float* ck = out + O_CK + (((size_t)(b * 2 + jm) * 256 + t) * 512 + grp * 128 + sub * 8);
                                *(f32x4*)ck = (f32x4){v[0], v[1], v[2], v[3]}; *(f32x4*)(ck + 4) = (f32x4){v[4], v[5], v[6], v[7]};
                            }
#pragma unroll
                            for (int e = 0; e < 8; ++e) { const float cs = samp ? rpf[j][e >> 1][(e & 1) * 2] : 1.f, sn = samp ? rpf[j][e >> 1][(e & 1) * 2 + 1] : 0.f;
                                const float p = __shfl_xor(v[e], 8); r[e] = (sub < 8) ? v[e] * cs - p * sn : v[e] * cs + p * sn; }
                            u32x4 w; w.x = cvt_pk_bf16(r[0], r[1]); w.y = cvt_pk_bf16(r[2], r[3]); w.z = cvt_pk_bf16(r[4], r[5]); w.w = cvt_pk_bf16(r[6], r[7]);
                            bf16_t* kd = samp ? KS + ((size_t)(b * LKS + t) * 512) : KP + (size_t)row * 512; *(u32x4*)(kd + grp * 128 + sub * 8) = w;
                        }
                        if (!samp) {
                            const u32x4 raw = rawv[j];
                            float* cv = out + O_CV + (((size_t)(b * 2 + jm) * 256 + t) * 512 + lane * 8);
                            *(f32x4*)cv = (f32x4){bf_lo(raw.x), bf_hi(raw.x), bf_lo(raw.y), bf_hi(raw.y)}; *(f32x4*)(cv + 4) = (f32x4){bf_lo(raw.z), bf_hi(raw.z), bf_lo(raw.w), bf_hi(raw.w)};
                        } } }
                }
                for (int r = gw; r < 2 * 8 * PAST; r += NGW) {
                    const int which = r / (8 * PAST), rr = r % (8 * PAST), b = rr / PAST, sidx = rr % PAST;
                    const float* src = (which ? AIN(I_CV) : AIN(I_CK)) + (((size_t)(b * 2 + jm) * PAST + sidx) * 512) + lane * 8;
                    const f32x4 a0 = *(const f32x4*)src, a1 = *(const f32x4*)(src + 4);
                    u32x4 w; w.x = cvt_pk_bf16(a0.x, a0.y); w.y = cvt_pk_bf16(a0.z, a0.w); w.z = cvt_pk_bf16(a1.x, a1.y); w.w = cvt_pk_bf16(a1.z, a1.w);
                    if (which) *(u32x4*)(VS + ((size_t)(b * PAST + sidx) * att::LDV) + lane * 8) = w;
                    else *(u32x4*)(KS + ((size_t)(b * LKS + 4096 + sidx) * 512) + lane * 8) = w;
                }
            }
            SEAM(base + 2);
            if (IN(base + 3) && EN(4)) {
                PHASE_BEGIN(); ATT_BUFS();
                _Pragma("unroll 1") for (int rep_ = 0; rep_ < REP_ATT; ++rep_)
#pragma unroll 1
                for (int i = 0; i * G + bx < 2048 + 256; ++i) {
                    const int lin = i * G + bx; int uid = lin;
                    if (G == 256 && lin < 2048) { const int xcd = bx & 7, slot = bx >> 3; uid = (xcd + 8 * (i >> 1)) * 64 + (i & 1) * 32 + slot; }
                    const bf16_t *qp, *kp, *vp, *vc; bf16_t* op; int seq, tok0, nown;
                    if (uid < 2048) {
                        const int gi = uid >> 6, w = uid & 63, b = gi >> 2, kvh = gi & 3, h = kvh * 4 + (w >> 4), qb = w & 15;
                        const size_t qrow0 = (size_t)MP + (size_t)b * 4096 + qb * 256;
                        qp = QKV + qrow0 * NQKV + h * 128; kp = KS + (size_t)b * LKS * 512 + kvh * 128; vp = QKV + ((size_t)MP + (size_t)b * 4096) * NQKV + 2560 + kvh * 128; vc = VS + (size_t)b * PAST * att::LDV + kvh * 128; nown = 4096 / 64; op = OB + qrow0 * DM + h * 128; seq = LKS; tok0 = qb * 256;
                    } else {
                        const int p = uid - 2048, b = p >> 4, h = p & 15, kvh = h >> 2;
                        const size_t qrow0 = (size_t)b * 256;
                        qp = QKV + qrow0 * NQKV + h * 128; kp = KP + qrow0 * 512 + kvh * 128; vp = QKV + qrow0 * NQKV + 2560 + kvh * 128; vc = vp; nown = 256 / 64; op = OB + qrow0 * DM + h * 128; seq = 256; tok0 = -1;
                    }
                    att::attn_dma_body(qp, kp, vp, op, seq, lds, wv_, AIN(I_QN) + jm * 128, (const f32x2*)(ws + WS_ROPE), tok0, vc, nown);
                }
            }
            SEAM(base + 3);
            if (IN(base + 4) && EN(5)) {
                PHASE_BEGIN(); ATT_BUFS(); LAYER_VALS();
                pg8::Gemm g{OB, (const bf16_t*)(ws + W_O + jm * W_O_SZ), MT, DM, DM, DM}; pg8::StaticOrder S; S.init(MT, DM, G, bx, WGM_N2048);
                pg8::EpiResid<L == 0> E{xin_p, xin_s, X16, modL + 2 * 2048, XG, XG, (const float*)(ws + WS_GM) + (size_t)((L * 2 + 1) * 9) * 2048, (const float*)(ws + WS_RGM) + (size_t)((L * 2 + 0) * 9) * 2048, RSS + (size_t)(2 * L + 1) * MT, nullptr, 0.f};
                pg8::gemm_phase<decltype(E), pg8::StaticOrder, true, true>(lds, g, S, E, wv_);
            }
            SEAM(base + 4);
        } else if (kind == 1) {
#define SSD_BUFS() bf16_t* ZX = (bf16_t*)(ws + B_ZX); bf16_t* YB = (bf16_t*)(out + O_X); bf16_t* halo = (bf16_t*)(ws + WS_HALO); float* DT = (float*)(ws + WS_DT); (void)ZX; (void)YB; (void)halo; (void)DT
            if (IN(base + 1) && EN(6)) {
                PHASE_BEGIN(); SSD_BUFS(); LAYER_VALS();
                pg8::Gemm g{XG, (const bf16_t*)(ws + W_SSDIN), MT, SSD_NPAD, DM, DM}; pg8::StaticOrder S; S.init(MT, SSD_NPAD, G, bx);
                pg8::EpiSsdIn E{ZX, halo, DT, pg8::RowMod{RSS + (size_t)(2 * L) * MT, BIAS + BO_SSD, SSD_NPAD}};
                pg8::gemm_phase<pg8::EpiSsdIn, pg8::StaticOrder, true, true>(lds, g, S, E, wv_);
#if REP_SSDIN > 1
                pg8::gemm_phase<pg8::EpiSsdIn, pg8::StaticOrder, true, true>(lds, g, S, E, wv_);
#endif
            }
            SEAM(base + 1);
            if (IN(base + 2) && EN(7)) { PHASE_BEGIN(); PHASE_IDS(); SSD_BUFS(); conv_inplace<true>(ZX, SSD_ZX, SSD_DI, SSD_XBC, halo, AIN(I_SCW), AIN(I_SCB), ((tid >> 6) * G + bx) * 64 + (tid & 63), G * NTHREADS); }
            SEAM(base + 2);
            if (IN(base + 3) && EN(8)) {
                PHASE_BEGIN(); SSD_BUFS();
_Pragma("unroll 1") for (int rep_ = 0; rep_ < REP_SSDSCAN; ++rep_)
#pragma unroll 1
                for (int u = bx; u < 256 + 512; u += G) {
                    const bool samp = u < 256; const int p0_ = samp ? u : u - 256, p = (G == 256) ? (samp ? (p0_ & 7) * 32 + (p0_ >> 3) : (p0_ & 7) * 64 + (p0_ >> 3)) : p0_, b = p >> 5, hp = p & 31;
                    const float* s0 = samp ? AIN(I_SSM) + (size_t)b * 2 * 64 * 8192 : nullptr;
                    float* sT = samp ? nullptr : out + O_SSM + (size_t)b * 2 * 64 * 8192;
                    ssd::scan_unit(lds, ZX, DT, YB, AIN(I_SDTB), AIN(I_SALOG), AIN(I_SD), AIN(I_SNORM), (float*)(ws + WS_RSS) + (size_t)9 * MT, s0, sT, samp ? MP + b * 4096 : b * 256, samp ? 32 : 2, hp, wv_);
                }
            }
            SEAM(base + 3);
            if (IN(base + 4) && EN(10)) {
                PHASE_BEGIN(); SSD_BUFS(); LAYER_VALS();
                pg8::Gemm g{ZX, (const bf16_t*)(ws + W_SSDOUT), MT, DM, SSD_DI, SSD_ZX}; pg8::StaticOrder S; S.init(MT, DM, G, bx, WGM_N2048);
                pg8::EpiResid<L == 0> E{xin_p, xin_s, X16, modL + 2 * 2048, XG, XG, (const float*)(ws + WS_GM) + (size_t)((L * 2 + 1) * 9) * 2048, (const float*)(ws + WS_RGM) + (size_t)((L * 2 + 0) * 9) * 2048, RSS + (size_t)(2 * L + 1) * MT, RSS + (size_t)9 * MT, 1.0f / SSD_DI};
                pg8::gemm_phase<decltype(E), pg8::StaticOrder, true, true>(lds, g, S, E, wv_);
            }
            SEAM(base + 4);
        } else {
#define LRU_BUFS() bf16_t* GR = (bf16_t*)(ws + B_GR); bf16_t* YL = (bf16_t*)(ws + B_YL); bf16_t* halo = (bf16_t*)(ws + WS_HALO); (void)GR; (void)YL; (void)halo
            if (IN(base + 1) && EN(11)) {
                PHASE_BEGIN(); LRU_BUFS(); LAYER_VALS();
                pg8::Gemm g{XG, (const bf16_t*)(ws + W_LRUIN), MT, 4096, DM, DM}; pg8::StaticOrder S; S.init(MT, 4096, G, bx);
                pg8::EpiBf16 E{GR, 4096, halo, 2048, 2048, pg8::RowMod{RSS + (size_t)(2 * L) * MT, BIAS + BO_LRU, 4096}};
                pg8::gemm_phase<pg8::EpiBf16, pg8::StaticOrder, true, true>(lds, g, S, E, wv_);
            }
            SEAM(base + 1);
            if (IN(base + 2) && EN(7)) { PHASE_BEGIN(); PHASE_IDS(); LRU_BUFS(); conv_inplace<false>(GR, 4096, 2048, 2048, halo, AIN(I_LCW), AIN(I_LCB), ((tid >> 6) * G + bx) * 64 + (tid & 63), G * NTHREADS); }
            SEAM(base + 2);
            if (IN(base + 3) && EN(12)) {
                PHASE_BEGIN(); LRU_BUFS();
_Pragma("unroll 1") for (int rep_ = 0; rep_ < REP_LRUSCAN; ++rep_)
#pragma unroll 1
                for (int u = bx; u < 256 + 512; u += G) {
                    const bool samp = u < 256; const int p0_ = samp ? u : u - 256, p = (G == 256) ? (samp ? (p0_ & 7) * 32 + (p0_ >> 3) : (p0_ & 7) * 64 + (p0_ >> 3)) : p0_, b = p >> 5, nb = (p >> 1) & 15, vh = p & 1;
                    const float* h0 = samp ? AIN(I_LRU) + (size_t)b * 2 * 2048 : nullptr;
                    float* hT = samp ? nullptr : out + O_LRU + (size_t)b * 2 * 2048;
                    lru::scan_unit(lds, GR, YL, (const bf16_t*)(ws + W_LRUG), AIN(I_LBA), AIN(I_LBI), AIN(I_LAP), h0, hT, samp ? MP + b * 4096 : b * 256, samp ? 32 : 2, nb, vh, wv_);
                }
            }
            SEAM(base + 3);
            if (IN(base + 4) && EN(13)) {
                PHASE_BEGIN(); LRU_BUFS(); LAYER_VALS();
                pg8::Gemm g{YL, (const bf16_t*)(ws + W_LRUOUT), MT, DM, DM, DM}; pg8::StaticOrder S; S.init(MT, DM, G, bx, WGM_N2048);
                pg8::EpiResid<L == 0> E{xin_p, xin_s, X16, modL + 2 * 2048, XG, XG, (const float*)(ws + WS_GM) + (size_t)((L * 2 + 1) * 9) * 2048, (const float*)(ws + WS_RGM) + (size_t)((L * 2 + 0) * 9) * 2048, RSS + (size_t)(2 * L + 1) * MT, nullptr, 0.f};
                pg8::gemm_phase<decltype(E), pg8::StaticOrder, true, true>(lds, g, S, E, wv_);
            }
            SEAM(base + 4);
        }
        if (IN(base + 11) && EN(14)) {
            PHASE_BEGIN(); LAYER_VALS();
            pg8::Gemm g{XG, (const bf16_t*)(ws + W_FFNIN + L * W_FFNIN_SZ), MT, NFFN, DM, DM}; pg8::StaticOrder S; S.init(MT, NFFN, G, bx, WGM_FFN1);
            pg8::EpiSwiGLU E{(bf16_t*)(ws + B_ACT), pg8::RowMod{RSS + (size_t)(2 * L + 1) * MT, BIAS + BO_FFN + L * BO_FFN_SZ, NFFN}};
            pg8::gemm_phase<pg8::EpiSwiGLU, pg8::StaticOrder, true, true>(lds, g, S, E, wv_);
#if REP_FFN1 > 1
            pg8::gemm_phase<pg8::EpiSwiGLU, pg8::StaticOrder, true, true>(lds, g, S, E, wv_);
#endif
        }
        SEAM(base + 11);
        if (IN(base + 12) && EN(15)) {
            PHASE_BEGIN(); LAYER_VALS();
            pg8::Gemm g{(const bf16_t*)(ws + B_ACT), (const bf16_t*)(ws + W_FFNOUT + L * W_FFNOUT_SZ), MT, DM, DFF, DFF}; pg8::StaticOrder S; S.init(MT, DM, G, bx, WGM_N2048);
            pg8::EpiResid<false> E{nullptr, nullptr, X16, modL + 5 * 2048, XG, (L < 3) ? XG : nullptr, (const float*)(ws + WS_GM) + (size_t)(((L < 3 ? L + 1 : 0) * 2 + 0) * 9) * 2048, (const float*)(ws + WS_RGM) + (size_t)((L * 2 + 1) * 9) * 2048, RSS + (size_t)(2 * L + 2) * MT, nullptr, 0.f};
            pg8::gemm_phase<decltype(E), pg8::StaticOrder, true, true>(lds, g, S, E, wv_);
        }
        SEAM(base + 12);
    }

__global__ void __launch_bounds__(NTHREADS, 2) fwd_kernel(Args args) {
    const int wv_ = __builtin_amdgcn_readfirstlane((int)(threadIdx.x >> 6));
    for (int u = threadIdx.x; u < (LDS_BYTES - RING_BYTES) / 4; u += NTHREADS) ((LAS unsigned*)((LAS unsigned char*)lds_raw + RING_BYTES))[u] = 0u;
    __syncthreads();
#if MK_SINGLE
    XcdBarrier bar = xcd_barrier_post((unsigned*)(args.ws + WS_CTL) + CW_BAR, (volatile LAS unsigned*)((LAS unsigned char*)lds_raw + MISC_OFF) + 8, wv_);
#else
    XcdBarrier bar; bar.bar = nullptr; bar.x = 0; bar.st = nullptr; bar.wv = wv_;
#endif
    const int lo = args.ph_lo, hi = args.ph_hi;

    if (IN(0) && EN(0)) {
        PHASE_BEGIN(); PHASE_IDS();
        _Pragma("unroll 1") for (int rep_ = 0; rep_ < REP_P0; ++rep_) {
        {
            LAS float* tab = (LAS float*)lds;
            LAS float* red = (LAS float*)(lds + 9 * 2048 * 4);
            const float* cvec = AIN(I_C); const float* cctx = AIN(I_CCTX);
            for (int i = tid; i < 9 * 2048; i += NTHREADS) { const int ci = i >> 11, k = i & 2047; const float c = ci < 8 ? cvec[ci * 2048 + k] : cctx[k]; tab[i] = c / (1.0f + expf(-c)); }
            __syncthreads();
            for (int unit = bx; unit < 4 * 192; unit += G) {
                const int layer = unit / 192, cb = unit % 192;
                const float* Wp = AIN(I_ADAW) + (size_t)layer * 2048 * 12288 + cb * 64 + lane;
                float acc[9];
#pragma unroll
                for (int c = 0; c < 9; ++c) acc[c] = 0.f;
                const int k0 = wave * 256;
#pragma unroll 32
                for (int kk = 0; kk < 256; ++kk) { const float wv = __builtin_nontemporal_load(&Wp[(size_t)(k0 + kk) * 12288]);
#pragma unroll
                    for (int c = 0; c < 9; ++c) acc[c] += tab[c * 2048 + k0 + kk] * wv; }
#pragma unroll
                for (int c = 0; c < 9; ++c) red[(wave * 9 + c) * 64 + lane] = acc[c];
                __syncthreads();
                for (int o = tid; o < 576; o += NTHREADS) { const int c = o >> 6, l = o & 63; float sacc = 0.f;
#pragma unroll
                    for (int w = 0; w < 8; ++w) sacc += red[(w * 9 + c) * 64 + l];
                    MOD[((size_t)layer * 9 + c) * 12288 + cb * 64 + l] = sacc + AIN(I_ADAB)[layer * 12288 + cb * 64 + l]; }
                __syncthreads();
            }
        }
        {
            f32x2* rope = (f32x2*)(ws + WS_ROPE);
            for (int i = bx * NTHREADS + tid; i < 64 * 32; i += G * NTHREADS) { const int pos = i >> 5, f = i & 31;
                const float inv = exp2f(-(float)f * (13.287712379549449f / 32.0f));
                const float ang = (float)pos * inv;
                const double a = (double)ang, tw = 6.283185307179586476925;
                const double r = a - tw * __builtin_rint(a / tw);
                rope[i] = (f32x2){__cosf((float)r), __sinf((float)r)}; }
        }
        {
            __syncthreads();
            LAS float* scr = (LAS float*)(lds + wave * 16384);
            const int gwi = wave * G + bx; int toff = 0;
            for (int j = 0; j < 2; ++j) {
                transpose_mat<0>(AIN(I_WQKV) + (size_t)j * DM * NQKV, NQKV, DM, (bf16_t*)(ws + W_QKV + j * W_QKV_SZ), NQKV, scr, gwi, NGW, lane, toff);
                transpose_mat<0>(AIN(I_WO) + (size_t)j * DM * DM, DM, DM, (bf16_t*)(ws + W_O + j * W_O_SZ), DM, scr, gwi, NGW, lane, toff);
            }
            transpose_mat<2>(AIN(I_SWIN), 10368, DM, (bf16_t*)(ws + W_SSDIN), SSD_NPAD, scr, gwi, NGW, lane, toff);
            transpose_mat<0>(AIN(I_SWOUT), DM, SSD_DI, (bf16_t*)(ws + W_SSDOUT), DM, scr, gwi, NGW, lane, toff);
            transpose_mat<0>(AIN(I_LWIN), 4096, DM, (bf16_t*)(ws + W_LRUIN), 4096, scr, gwi, NGW, lane, toff);
            transpose_mat<0>(AIN(I_LWOUT), DM, DM, (bf16_t*)(ws + W_LRUOUT), DM, scr, gwi, NGW, lane, toff);
            for (int blk = 0; blk < 64; ++blk) {
                const int d = blk >> 5, gate = (blk >> 4) & 1, n = blk & 15;
                const float* src = (gate ? AIN(I_LWI) : AIN(I_LWA)) + ((size_t)(d * 16 + n)) * 128 * 128;
                transpose_mat<0>(src, 128, 128, (bf16_t*)(ws + W_LRUG) + (size_t)blk * 128 * 128, 128, scr, gwi, NGW, lane, toff);
            }
            for (int l = 0; l < 4; ++l) {
                transpose_mat<1>(AIN(I_FWIN) + (size_t)l * DM * NFFN, NFFN, DM, (bf16_t*)(ws + W_FFNIN + l * W_FFNIN_SZ), NFFN, scr, gwi, NGW, lane, toff);
                transpose_mat<0>(AIN(I_FWOUT) + (size_t)l * DFF * DM, DM, DFF, (bf16_t*)(ws + W_FFNOUT + l * W_FFNOUT_SZ), DM, scr, gwi, NGW, lane, toff);
            }
            __syncthreads();
        }
        }
    }
    SEAM(0);

    layer_phases<0>(lo, hi, bar, wv_); layer_phases<1>(lo, hi, bar, wv_); layer_phases<2>(lo, hi, bar, wv_); layer_phases<3>(lo, hi, bar, wv_);
    if (IN(PH_FINAL) && EN(16)) {
        PHASE_BEGIN(); PHASE_IDS();
        const float* fn = AIN(I_FNORM); const float* rss = (const float*)(ws + WS_RSS) + (size_t)8 * MT; const bf16_t* X16 = (const bf16_t*)(ws + WS_X16);
        for (int row = gw; row < MT; row += NGW) {
            const u32x4* x8 = (const u32x4*)(X16 + (size_t)row * DM) + lane; f32x4* y4 = (f32x4*)(out + O_X + (size_t)row * DM) + 2 * lane;
            const float rstd = 1.0f / sqrtf(rss[row] * (1.0f / DM) + EPS);
            u32x4 v[4];
#pragma unroll
            for (int j = 0; j < 4; ++j) v[j] = x8[64 * j];
#pragma unroll
            for (int j = 0; j < 4; ++j) { const f32x4 g0 = ((const f32x4*)fn)[128 * j + 2 * lane], g1 = ((const f32x4*)fn)[128 * j + 2 * lane + 1];
                const f32x4 a = {bf_lo(v[j].x), bf_hi(v[j].x), bf_lo(v[j].y), bf_hi(v[j].y)}, b = {bf_lo(v[j].z), bf_hi(v[j].z), bf_lo(v[j].w), bf_hi(v[j].w)};
                y4[128 * j] = a * rstd * g0; y4[128 * j + 1] = b * rstd * g1; }
        }
    }
}

extern "C" void kernel_launch(void* const* d_in, const int* in_sizes, int n_in, void* d_out, int out_size, void* d_ws, size_t ws_size, hipStream_t stream) {
    static int grid = 0;
    if (grid == 0) {
        if (n_in != 36 || (size_t)out_size != O_END || ws_size < WS_END) { fprintf(stderr, "kernel_launch: shape mismatch n_in %d out %d ws %zu (need %zu)\n", n_in, out_size, ws_size, (size_t)WS_END); grid = -1; return; }
        int dev = 0, cus = 0, per_cu = 0;
        if (hipGetDevice(&dev) != hipSuccess || hipDeviceGetAttribute(&cus, hipDeviceAttributeMultiprocessorCount, dev) != hipSuccess) { grid = -1; return; }
        if (hipFuncSetAttribute((const void*)fwd_kernel, hipFuncAttributeMaxDynamicSharedMemorySize, LDS_BYTES) != hipSuccess) { fprintf(stderr, "kernel_launch: hipFuncSetAttribute failed\n"); grid = -1; return; }
        if (hipOccupancyMaxActiveBlocksPerMultiprocessor(&per_cu, (const void*)fwd_kernel, NTHREADS, LDS_BYTES) != hipSuccess || per_cu < 1)
            fprintf(stderr, "kernel_launch: occupancy query reports %d\n", per_cu);
        (void)hipGetLastError();
        grid = cus;
    }
    if (grid < 0) return;
    (void)hipMemsetAsync((char*)d_ws + WS_CTL, 0, CTL_ZERO_BYTES, stream);
    (void)hipMemsetAsync((char*)d_ws + WS_RSS, 0, RSS_BYTES, stream);
    Args a{};
    for (int i = 0; i < 36; ++i) a.in[i] = (const float*)d_in[i];
    a.out = (float*)d_out; a.ws = (unsigned char*)d_ws;
#if MK_SINGLE
    a.ph_lo = 0; a.ph_hi = PH_END;
    hipLaunchKernelGGL(fwd_kernel, dim3(grid), dim3(NTHREADS), LDS_BYTES, stream, a);
#else
    static const int phases[] = {0,
        1, 2, 3, 4, 5, 12, 13,
        18, 19, 20, 21, 28, 29,
        34, 35, 36, 37, 44, 45,
        50, 51, 52, 53, 60, 61,
        65};
    for (unsigned i = 0; i < sizeof(phases) / sizeof(phases[0]); ++i) {
        a.ph_lo = phases[i]; a.ph_hi = phases[i] + 1;
        hipLaunchKernelGGL(fwd_kernel, dim3(grid), dim3(NTHREADS), LDS_BYTES, stream, a);
    }
#endif
}
```

```cpp
#include <hip/hip_runtime.h>
#include <cstdio>
#include <cstdint>

#ifndef MK_SINGLE
#define MK_SINGLE 1
#endif

#ifndef REP_FFN1
#define REP_FFN1 1
#endif
#ifndef REP_ATT
#define REP_ATT 1
#endif
#ifndef REP_SSDSCAN
#define REP_SSDSCAN 1
#endif
#ifndef REP_LRUSCAN
#define REP_LRUSCAN 1
#endif
#ifndef REP_NORM
#define REP_NORM 1
#endif
#ifndef REP_QKV
#define REP_QKV 1
#endif
#ifndef REP_SSDIN
#define REP_SSDIN 1
#endif
#ifndef REP_P0
#define REP_P0 1
#endif
#ifndef WGM_N2048
#define WGM_N2048 4
#endif
#ifndef WGM_FFN1
#define WGM_FFN1 4
#endif
#ifndef ENMASK
#define ENMASK 0xFFFFFFFFu
#endif
#define EN(b) ((ENMASK >> (b)) & 1u)
#define LAS __attribute__((address_space(3)))
#define GAS __attribute__((address_space(1)))
typedef unsigned short bf16_t;
typedef short bf16x8 __attribute__((ext_vector_type(8)));
typedef short s16x4 __attribute__((ext_vector_type(4)));
typedef float f32x4 __attribute__((ext_vector_type(4)));
typedef float f32x2 __attribute__((ext_vector_type(2)));
typedef float f32x16 __attribute__((ext_vector_type(16)));
typedef unsigned u32x4 __attribute__((ext_vector_type(4)));
typedef unsigned u32x2 __attribute__((ext_vector_type(2)));

constexpr int DM = 2048, MP = 4096, MS = 32768, MT = MP + MS;
constexpr int NQKV = 3072, DFF = 5632, NFFN = 11264;
constexpr int SSD_NPAD = 10496, SSD_ZX = 10240, SSD_DI = 4096, SSD_XBC = 6144;
constexpr int PAST = 512, LKS = 4096 + PAST;
constexpr float EPS = 1e-6f;
constexpr int NWAVES = 8, NTHREADS = 512;

constexpr size_t MiB = 1u << 20;
constexpr size_t WS_CTL = 0, CTL_ZERO_BYTES = 1 * MiB;
constexpr size_t WS_MOD = 1 * MiB;
constexpr size_t WS_GM = 3 * MiB + 64 * 1024;
constexpr size_t WS_ROPE = 3 * MiB;
constexpr size_t WS_RGM = 9 * MiB + 256 * 1024;
constexpr size_t WS_HALO = 4 * MiB;
constexpr size_t WS_DT = 10 * MiB;
constexpr size_t WS_RSS = 28 * MiB;
constexpr size_t RSS_BYTES = (size_t)10 * 36864 * 4;
constexpr size_t WS_BIAS = 29 * MiB + 512 * 1024;
constexpr int BO_QKV = 0, BO_SSD = 2 * 9 * 3072, BO_LRU = BO_SSD + 9 * 10496, BO_FFN = BO_LRU + 9 * 4096, BO_FFN_SZ = 9 * 11264;
constexpr size_t WS_W = 32 * MiB;
constexpr size_t W_QKV = WS_W, W_QKV_SZ = (size_t)NQKV * DM * 2;
constexpr size_t W_O = W_QKV + 2 * W_QKV_SZ, W_O_SZ = (size_t)DM * DM * 2;
constexpr size_t W_SSDIN = W_O + 2 * W_O_SZ, W_SSDIN_SZ = (size_t)SSD_NPAD * DM * 2;
constexpr size_t W_SSDOUT = W_SSDIN + W_SSDIN_SZ, W_SSDOUT_SZ = (size_t)DM * SSD_DI * 2;
constexpr size_t W_LRUIN = W_SSDOUT + W_SSDOUT_SZ, W_LRUIN_SZ = (size_t)4096 * DM * 2;
constexpr size_t W_LRUOUT = W_LRUIN + W_LRUIN_SZ, W_LRUOUT_SZ = (size_t)DM * DM * 2;
constexpr size_t W_LRUG = W_LRUOUT + W_LRUOUT_SZ, W_LRUG_SZ = (size_t)64 * 128 * 128 * 2;
constexpr size_t W_FFNIN = W_LRUG + W_LRUG_SZ, W_FFNIN_SZ = (size_t)NFFN * DM * 2;
constexpr size_t W_FFNOUT = W_FFNIN + 4 * W_FFNIN_SZ, W_FFNOUT_SZ = (size_t)DM * DFF * 2;
constexpr size_t W_END = W_FFNOUT + 4 * W_FFNOUT_SZ;
constexpr size_t WS_H = 420 * MiB;
constexpr size_t WS_X16 = WS_H + 144 * MiB;
constexpr size_t WS_BIG = 708 * MiB;
constexpr size_t WS_END = WS_BIG + 720 * MiB;
static_assert(W_END <= WS_H, "weights overflow");
constexpr size_t B_QKV = WS_BIG, B_O = WS_BIG + 216 * MiB, B_KS = WS_BIG + 360 * MiB, B_VS = WS_BIG + 396 * MiB, B_KP = WS_BIG + 432 * MiB, B_VP = WS_BIG + 436 * MiB;
constexpr size_t B_ACT = WS_BIG;
constexpr size_t B_ZX = WS_BIG;
constexpr size_t B_GR = WS_BIG, B_YL = WS_BIG + 288 * MiB;
constexpr int CW_BAR = 4096;

constexpr size_t O_X = 0, O_CK = (size_t)MT * DM, O_CV = O_CK + (size_t)16 * 2 * 256 * 512, O_SSM = O_CV + (size_t)16 * 2 * 256 * 512,
                 O_LRU = O_SSM + (size_t)16 * 2 * 64 * 64 * 128, O_END = O_LRU + (size_t)16 * 2 * 2048;

constexpr int RING_BYTES = 131072, MISC_OFF = RING_BYTES + 320, LDS_BYTES = 147456;

#define LDS_WAIT() asm volatile("s_waitcnt lgkmcnt(0)" ::: "memory")
#define VM_WAIT() asm volatile("s_waitcnt vmcnt(0)" ::: "memory")
#define LBAR() do { asm volatile("s_waitcnt lgkmcnt(0)" ::: "memory"); __builtin_amdgcn_s_barrier(); asm volatile("" ::: "memory"); } while (0)

__device__ __forceinline__ int lane_id() { return (int)__builtin_amdgcn_mbcnt_hi(~0u, __builtin_amdgcn_mbcnt_lo(~0u, 0u)); }
__device__ __forceinline__ int opaque_tid(int wv) { asm volatile("" : "+s"(wv)); int t = wv * 64 + lane_id(); asm volatile("" : "+v"(t)); return t; }
__device__ __forceinline__ unsigned cvt_pk_bf16(float lo, float hi) { unsigned r; asm volatile("v_cvt_pk_bf16_f32 %0, %1, %2" : "=v"(r) : "v"(lo), "v"(hi)); return r; }
__device__ __forceinline__ float bf_lo(unsigned w) { return __uint_as_float(w << 16); }
__device__ __forceinline__ float bf_hi(unsigned w) { return __uint_as_float(w & 0xffff0000u); }
__device__ __forceinline__ float silu_f(float x) { return x * __builtin_amdgcn_rcpf(1.0f + __expf(-x)); }
__device__ __forceinline__ float wave_sum(float v) {
#pragma unroll
    for (int o = 1; o < 64; o <<= 1) v += __shfl_xor(v, o);
    return v;
}

#define XB_TMO      128
#define XB_XCNT(j)  (256  + 64 * (j))
#define XB_XSUB(j)  (1280 + 64 * (j))
#define XB_XGEN(j)  (2304 + 64 * (j))
#define XB_TOP      3328
#define XB_TOPGEN   3392
#define XCD_BAR_WORDS 3456
#define XB_SPIN_CAP (1u << 22)
__device__ __forceinline__ unsigned xb_ld(unsigned* p)              { return __hip_atomic_load(p, __ATOMIC_RELAXED, __HIP_MEMORY_SCOPE_AGENT); }
__device__ __forceinline__ unsigned xb_add(unsigned* p, unsigned v) { return __hip_atomic_fetch_add(p, v, __ATOMIC_RELAXED, __HIP_MEMORY_SCOPE_AGENT); }
__device__ __forceinline__ unsigned xb_xcc_id() { return (unsigned)__builtin_amdgcn_s_getreg((3 << 11) | 20) & 0xFu; }
#define XB_SPIN(cond, bar) do { unsigned _sp = 0; while (cond) { __builtin_amdgcn_s_sleep(1); \
    if ((++_sp & 255u) == 0u) { if (xb_ld(&(bar)[XB_TMO])) break; if (_sp > XB_SPIN_CAP) { atomicAdd(&(bar)[XB_TMO], 1u); break; } } } } while (0)
struct XcdBarrier { unsigned* bar; unsigned x; volatile LAS unsigned* st; int wv; };
__device__ __forceinline__ XcdBarrier xcd_barrier_post(unsigned* bar, volatile LAS unsigned* st, int wv) {
    XcdBarrier b; b.bar = bar; b.x = xb_xcc_id(); b.st = st; b.wv = wv;
    if (threadIdx.x == 0) (void)xb_add(&bar[XB_XCNT(b.x)], 1u);
    return b;
}
__device__ __forceinline__ void xcd_barrier_complete(unsigned* bar, unsigned x, unsigned& nloc, unsigned& nx) {
    const unsigned G = gridDim.x * gridDim.y * gridDim.z;
    unsigned sum, cnt, mine, sp = 0u;
    for (;;) {
        sum = 0u; cnt = 0u; mine = 0u;
#pragma unroll
        for (unsigned j = 0; j < 16; ++j) { const unsigned c = xb_ld(&bar[XB_XCNT(j)]); sum += c; cnt += (c > 0u) ? 1u : 0u; mine = (j == x) ? c : mine; }
        if (sum == G) break;
        __builtin_amdgcn_s_sleep(1);
        if ((++sp & 255u) == 0u) { if (xb_ld(&bar[XB_TMO])) break; if (sp > XB_SPIN_CAP) { atomicAdd(&bar[XB_TMO], 1u); break; } }
    }
    nloc = mine > 0u ? mine : 1u; nx = cnt > 0u ? cnt : 1u;
}
__device__ __forceinline__ void xcd_barrier(const XcdBarrier& b) {
    asm volatile("s_waitcnt vmcnt(0)" ::: "memory");
    __syncthreads();
    if (b.wv == 0 && lane_id() == 0) {
        unsigned* bar = b.bar;
        __builtin_amdgcn_s_waitcnt(0);
        unsigned nloc = b.st[0], nx = b.st[1];
        if (nloc == 0u) { xcd_barrier_complete(bar, b.x, nloc, nx); b.st[0] = nloc; b.st[1] = nx; }
        const unsigned old = xb_add(&bar[XB_XSUB(b.x)], 1u);
        const unsigned gen = old / nloc;
        if (old + 1u == (gen + 1u) * nloc) {
            __builtin_amdgcn_fence(__ATOMIC_RELEASE, "agent");
            asm volatile("s_waitcnt vmcnt(0)" ::: "memory");
            const unsigned og = xb_add(&bar[XB_TOP], 1u);
            const unsigned tg = og / nx;
            if (og + 1u == (tg + 1u) * nx) xb_add(&bar[XB_TOPGEN], 1u);
            else XB_SPIN(xb_ld(&bar[XB_TOPGEN]) == tg, bar);
            __builtin_amdgcn_fence(__ATOMIC_ACQUIRE, "agent");
            xb_add(&bar[XB_XGEN(b.x)], 1u);
            asm volatile("s_waitcnt vmcnt(0)" ::: "memory");
        } else {
            XB_SPIN(xb_ld(&bar[XB_XGEN(b.x)]) == gen, bar);
            __builtin_amdgcn_fence(__ATOMIC_ACQUIRE, "agent");
            asm volatile("s_waitcnt vmcnt(0)" ::: "memory");
        }
    }
    __syncthreads();
}

namespace pg8 {
constexpr int STAGE_SLOT_OFF = RING_BYTES + 1024, STAGE_SLOT_BYTES = 3072;
constexpr int BM = 256, BK = 64, HALF = 128, HTB = HALF * BK * 2, STAGE_BYTES = 8 * HTB, NXCD = 8, WGM = 4;
__host__ __device__ __forceinline__ int lds_byte(int r, int c) { const int st = (r >> 4) * 2 + (c >> 5), rr = r & 15, cc = c & 31, ob = rr * 64 + cc * 2; return st * 1024 + (ob ^ (((ob >> 9) & 1) << 5)); }
__host__ __device__ __forceinline__ void stage_rc(int b, int& R, int& C) { const int st = b / 1024, sb = b % 1024, swz = sb ^ (((sb >> 9) & 1) << 5); R = (st >> 1) * 16 + swz / 64; C = (st & 1) * 32 + (swz % 64) / 2; }
__host__ __device__ __forceinline__ int perm32(int rho) { const int n = rho >> 4, i = rho & 15; return 8 * (i >> 2) + 4 * n + (i & 3); }
struct Unit { int pm, pn; };
struct Gemm { const bf16_t* A; const bf16_t* Bt; int M, N, K, lda; };
struct StaticOrder {
    int nM, nN, nwg, G, c, wgm;
    __host__ __device__ void init(int M, int N, int G_, int c_, int wgm_ = WGM) { nM = M / BM; nN = N / BM; nwg = nM * nN; G = G_; c = c_; wgm = wgm_; }
    __host__ __device__ bool next(int i, Unit& u) const {
        const long L = (long)i * G + c; if (L >= nwg) return false;
        int wgid = (int)L; { const int q = nwg / NXCD, r = nwg % NXCD, xcd = wgid % NXCD, off = wgid / NXCD; wgid = (xcd < r ? xcd * (q + 1) : r * (q + 1) + (xcd - r) * q) + off; }
        const int nig = wgm * nN, gid = wgid / nig, fm = gid * wgm, gsz = (nM - fm) < wgm ? (nM - fm) : wgm;
        u.pm = fm + ((wgid % nig) % gsz); u.pn = (wgid % nig) / gsz; return true;
    }
    __device__ __forceinline__ void a_ready(const Unit&) const {}
    __device__ __forceinline__ void done(const Unit&) const {}
};
template <class Epi, class Sched, bool ALIGN_EPI = false, bool SP2 = false>
__device__ __forceinline__ void gemm_phase(LAS unsigned char* lds, const Gemm g, const Sched& S, const Epi& E, const int wv_) {
    const int tid = opaque_tid(wv_), wid = __builtin_amdgcn_readfirstlane(tid >> 6), lane = tid & 63, wr = wid >> 2, wc = wid & 3, fr = lane & 15, fq = lane >> 4;
    const int K = g.K, nt = K / BK, lda = g.lda;
    unsigned voffA[2], voffB[2];
#pragma unroll
    for (int i = 0; i < 2; ++i) { int R, C; stage_rc(tid * 16 + i * 8192, R, C); const int Rb = Epi::PERM ? ((R & ~31) + perm32(R & 31)) : R;
        voffA[i] = (unsigned)(R * lda + C) * 2u; voffB[i] = (unsigned)(Rb * K + C) * 2u; }
    const size_t kstep = (size_t)(BK * 2);
    const size_t hstepA = (size_t)HALF * lda * 2, hstepB = (size_t)HALF * K * 2;
    const size_t tstepA = 2 * hstepA, tstepB = 2 * hstepB;
    const unsigned ldsw = (unsigned)wid * 1024u;
    const int aoff = lds_byte(wr * 64 + fr, fq * 8), boff = lds_byte(wc * 32 + fr, fq * 8);
#define PG8_SA(b, h) (((b) * 2 + (h)) * HTB)
#define PG8_SB(b, h) ((4 + (b) * 2 + (h)) * HTB)
#define PG8_STAGE(bufoff, gbase, voff) do { _Pragma("unroll") for (int _i = 0; _i < 2; ++_i) { unsigned vo_ = (voff)[_i]; asm volatile("" : "+v"(vo_));     \
        __builtin_amdgcn_global_load_lds((const unsigned*)((const char*)(gbase) + vo_), (LAS unsigned*)(lds + (bufoff) + ldsw + _i * 8192), 16, 0, 0); } } while (0)
#define PG8_LDA(dst, b, h) do { _Pragma("unroll") for (int m = 0; m < 4; ++m) _Pragma("unroll") for (int k = 0; k < 2; ++k) dst[m][k] = *(const LAS bf16x8*)(lds + PG8_SA(b, h) + aoff + m * 2048 + k * 1024); } while (0)
#define PG8_LDB(dst, b, h) do { _Pragma("unroll") for (int n = 0; n < 2; ++n) _Pragma("unroll") for (int k = 0; k < 2; ++k) dst[n][k] = *(const LAS bf16x8*)(lds + PG8_SB(b, h) + boff + n * 2048 + k * 1024); } while (0)
#define PG8_MMA(ai, bj, At, Bt) do { __builtin_amdgcn_s_setprio(1); _Pragma("unroll") for (int m = 0; m < 4; ++m) _Pragma("unroll") for (int n = 0; n < 2; ++n) _Pragma("unroll") for (int k = 0; k < 2; ++k) \
        acc[ai][bj][m][n] = __builtin_amdgcn_mfma_f32_16x16x32_bf16(Bt[n][k], At[m][k], acc[ai][bj][m][n], 0, 0, 0); __builtin_amdgcn_s_setprio(0); } while (0)
#define PG8_WAIT_V(n) asm volatile("s_waitcnt vmcnt(" #n ")" ::: "memory")
#define PG8_WAIT_L(n) asm volatile("s_waitcnt lgkmcnt(" #n ")" ::: "memory")
#define PG8_BAR __builtin_amdgcn_s_barrier()
#define PG8_SCHED __builtin_amdgcn_sched_barrier(0)
    Unit cur, nxt; int ui = 0;
    if (!S.next(0, cur)) return;
    f32x4 acc[2][2][4][2];
#pragma unroll
    for (int a = 0; a < 2; ++a)
#pragma unroll
        for (int b = 0; b < 2; ++b)
#pragma unroll
            for (int m = 0; m < 4; ++m)
#pragma unroll
                for (int n = 0; n < 2; ++n) acc[a][b][m][n] = (f32x4){0.f, 0.f, 0.f, 0.f};
    bf16x8 At[4][2], B0[2][2], B1[2][2];
    const char* cA = (const char*)g.A + (size_t)cur.pm * tstepA; const char* cB = (const char*)g.Bt + (size_t)cur.pn * tstepB;
    S.a_ready(cur);
    if constexpr (SP2) {
        PG8_STAGE(PG8_SB(0, 0), cB, voffB); PG8_STAGE(PG8_SB(0, 1), cB + hstepB, voffB); PG8_STAGE(PG8_SA(0, 0), cA, voffA); PG8_STAGE(PG8_SA(0, 1), cA + hstepA, voffA);
        if (wr == 1) PG8_BAR;
        PG8_WAIT_V(2); PG8_BAR;
        PG8_STAGE(PG8_SB(1, 0), cB + kstep, voffB); PG8_STAGE(PG8_SA(1, 0), cA + kstep, voffA); PG8_STAGE(PG8_SB(1, 1), cB + hstepB + kstep, voffB);
        PG8_WAIT_V(6); PG8_BAR;
    } else {
        PG8_STAGE(PG8_SB(0, 0), cB, voffB); PG8_STAGE(PG8_SA(0, 0), cA, voffA); PG8_STAGE(PG8_SB(0, 1), cB + hstepB, voffB); PG8_STAGE(PG8_SA(0, 1), cA + hstepA, voffA);
        if (wr == 1) PG8_BAR;
        PG8_WAIT_V(4); PG8_BAR;
        PG8_STAGE(PG8_SB(1, 0), cB + kstep, voffB); PG8_STAGE(PG8_SA(1, 0), cA + kstep, voffA); PG8_STAGE(PG8_SB(1, 1), cB + hstepB + kstep, voffB);
        PG8_WAIT_V(6); PG8_BAR;
    }
    for (;;) {
        const bool has_next = S.next(ui + 1, nxt);
        const char* nA = has_next ? (const char*)g.A + (size_t)nxt.pm * tstepA : cA; const char* nB = has_next ? (const char*)g.Bt + (size_t)nxt.pn * tstepB : cB;
        for (int t = 0; t < nt; t += 2) {
            const bool last = (t == nt - 2);
            const char* a1 = cA + (size_t)(t + 1) * kstep;
            const char* a2 = last ? nA : cA + (size_t)(t + 2) * kstep; const char* b2 = last ? nB : cB + (size_t)(t + 2) * kstep;
            const char* a3 = a2 + kstep; const char* b3 = b2 + kstep;
            if (last && has_next) S.a_ready(nxt);
            if constexpr (Epi::STAGED) { if (t == 0) { __builtin_amdgcn_global_load_lds((const unsigned*)E.stage_src(cur, tid), (LAS unsigned*)(lds + STAGE_SLOT_OFF + (ui & 1) * STAGE_SLOT_BYTES + wid * 256), 4, 0, 0);
                if constexpr (Epi::STAGED3) { if (wid < 4) __builtin_amdgcn_global_load_lds((const unsigned*)E.stage_src3(cur, tid), (LAS unsigned*)(lds + STAGE_SLOT_OFF + (ui & 1) * STAGE_SLOT_BYTES + 2048 + wid * 256), 4, 0, 0); } } }
            if constexpr (SP2) {
            PG8_LDB(B0, 0, 0); PG8_LDB(B1, 0, 1); PG8_SCHED; PG8_LDA(At, 0, 0); PG8_STAGE(PG8_SA(1, 1), a1 + hstepA, voffA);
            PG8_WAIT_V(8); PG8_WAIT_L(0); PG8_BAR; PG8_MMA(0, 0, At, B0); PG8_MMA(0, 1, At, B1); PG8_BAR; PG8_SCHED;
            PG8_LDA(At, 0, 1); PG8_STAGE(PG8_SB(0, 0), b2, voffB); PG8_STAGE(PG8_SB(0, 1), b2 + hstepB, voffB); PG8_STAGE(PG8_SA(0, 0), a2, voffA);
            PG8_WAIT_V(8); PG8_WAIT_L(0); PG8_BAR; PG8_MMA(1, 0, At, B0); PG8_MMA(1, 1, At, B1); PG8_BAR; PG8_SCHED;
            PG8_LDB(B0, 1, 0); PG8_LDB(B1, 1, 1); PG8_SCHED; PG8_LDA(At, 1, 0); PG8_STAGE(PG8_SA(0, 1), a2 + hstepA, voffA);
            PG8_WAIT_V(8); PG8_WAIT_L(0); PG8_BAR; PG8_MMA(0, 0, At, B0); PG8_MMA(0, 1, At, B1); PG8_BAR; PG8_SCHED;
            PG8_LDA(At, 1, 1); PG8_STAGE(PG8_SB(1, 0), b3, voffB); PG8_STAGE(PG8_SB(1, 1), b3 + hstepB, voffB); PG8_STAGE(PG8_SA(1, 0), a3, voffA);
            PG8_WAIT_V(8); PG8_WAIT_L(0); PG8_BAR; PG8_MMA(1, 0, At, B0); PG8_MMA(1, 1, At, B1); PG8_BAR; PG8_SCHED;
            } else {
            PG8_LDB(B0, 0, 0); PG8_SCHED; PG8_LDA(At, 0, 0); PG8_STAGE(PG8_SA(1, 1), a1 + hstepA, voffA);
            PG8_WAIT_L(8); PG8_BAR; PG8_WAIT_L(0); PG8_MMA(0, 0, At, B0); PG8_BAR; PG8_SCHED;
            PG8_LDB(B1, 0, 1); PG8_STAGE(PG8_SB(0, 0), b2, voffB);
            PG8_BAR; PG8_WAIT_L(0); PG8_MMA(0, 1, At, B1); PG8_BAR;
            PG8_LDA(At, 0, 1); PG8_STAGE(PG8_SA(0, 0), a2, voffA);
            PG8_BAR; PG8_WAIT_L(0); PG8_MMA(1, 0, At, B0); PG8_BAR; PG8_SCHED;
            PG8_STAGE(PG8_SB(0, 1), b2 + hstepB, voffB);
            PG8_WAIT_V(6); PG8_BAR; PG8_MMA(1, 1, At, B1); PG8_BAR;
            PG8_LDB(B0, 1, 0); PG8_SCHED; PG8_LDA(At, 1, 0); PG8_STAGE(PG8_SA(0, 1), a2 + hstepA, voffA);
            PG8_WAIT_L(8); PG8_BAR; PG8_WAIT_L(0); PG8_MMA(0, 0, At, B0); PG8_BAR; PG8_SCHED;
            PG8_LDB(B1, 1, 1); PG8_STAGE(PG8_SB(1, 0), b3, voffB);
            PG8_BAR; PG8_WAIT_L(0); PG8_MMA(0, 1, At, B1); PG8_BAR;
            PG8_LDA(At, 1, 1); PG8_STAGE(PG8_SA(1, 0), a3, voffA);
            PG8_BAR; PG8_WAIT_L(0); PG8_MMA(1, 0, At, B0); PG8_BAR; PG8_SCHED;
            PG8_STAGE(PG8_SB(1, 1), b3 + hstepB, voffB);
            PG8_WAIT_V(6); PG8_BAR; PG8_MMA(1, 1, At, B1); PG8_BAR;
            }
        }
        if constexpr (ALIGN_EPI) { if (wr == 0) PG8_BAR; }
        E(acc, cur, wr, wc, fr, fq, (const LAS float*)(lds + STAGE_SLOT_OFF + (ui & 1) * STAGE_SLOT_BYTES)); S.done(cur);
        if (!has_next) break;
#pragma unroll
        for (int a = 0; a < 2; ++a)
#pragma unroll
            for (int b = 0; b < 2; ++b)
#pragma unroll
                for (int m = 0; m < 4; ++m)
#pragma unroll
                    for (int n = 0; n < 2; ++n) acc[a][b][m][n] = (f32x4){0.f, 0.f, 0.f, 0.f};
        cur = nxt; cA = nA; cB = nB; ++ui;
        if constexpr (ALIGN_EPI) { if (wr == 1) PG8_BAR; }
    }
    PG8_WAIT_V(0);
    if constexpr (!ALIGN_EPI) { if (wr == 0) PG8_BAR; }
    PG8_BAR;
#undef PG8_SA
#undef PG8_SB
#undef PG8_STAGE
#undef PG8_LDA
#undef PG8_LDB
#undef PG8_MMA
#undef PG8_WAIT_V
#undef PG8_WAIT_L
#undef PG8_BAR
#undef PG8_SCHED
}

struct RowMod {
    const float* rss;
    const float* bias;
    int nb;
    __device__ __forceinline__ const float* src(const Unit& u, int tid) const {
        const int ci = u.pm < 16 ? 8 : ((u.pm - 16) >> 4);
        return tid < 256 ? rss + u.pm * BM + tid : bias + (size_t)ci * nb + u.pn * BM + (tid - 256);
    }
    static __device__ __forceinline__ void rstd8(float (&rs)[2][4], const LAS float* slot, int rl0) {
#pragma unroll
        for (int ai = 0; ai < 2; ++ai)
#pragma unroll
            for (int m = 0; m < 4; ++m) rs[ai][m] = 1.0f / sqrtf(slot[rl0 + ai * HALF + m * 16] * (1.0f / DM) + EPS);
    }
    static __device__ __forceinline__ void bias8(f32x4 (&bv)[2][2], const LAS float* slot, int cl0) {
#pragma unroll
        for (int bj = 0; bj < 2; ++bj) { bv[bj][0] = *(const LAS f32x4*)(slot + 256 + cl0 + bj * HALF); bv[bj][1] = *(const LAS f32x4*)(slot + 256 + cl0 + bj * HALF + 4); }
    }
};
struct EpiBf16 {
    static constexpr bool PERM = true;
    static constexpr bool STAGED = true, STAGED3 = false;
    bf16_t* O; int ldc; bf16_t* halo; int halo_col0, halo_ld; RowMod rm;
    __device__ __forceinline__ const float* stage_src(const Unit& u, int tid) const { return rm.src(u, tid); }
    __device__ __forceinline__ void operator()(const f32x4 (&acc)[2][2][4][2], const Unit& u, int wr, int wc, int fr, int fq, const LAS float* slot) const {
        const int row0 = u.pm * BM + wr * 64 + fr; const int col0 = u.pn * BM + wc * 32 + 8 * fq;
        float rs[2][4]; RowMod::rstd8(rs, slot, wr * 64 + fr); f32x4 bv[2][2]; RowMod::bias8(bv, slot, wc * 32 + 8 * fq);
#pragma unroll
        for (int ai = 0; ai < 2; ++ai)
#pragma unroll
            for (int m = 0; m < 4; ++m) { bf16_t* rowp = O + (size_t)(row0 + ai * HALF + m * 16) * ldc + col0;
#pragma unroll
                for (int bj = 0; bj < 2; ++bj) { const f32x4 v0 = acc[ai][bj][m][0] * rs[ai][m] + bv[bj][0], v1 = acc[ai][bj][m][1] * rs[ai][m] + bv[bj][1];
                    u32x4 w; w.x = cvt_pk_bf16(v0[0], v0[1]); w.y = cvt_pk_bf16(v0[2], v0[3]); w.z = cvt_pk_bf16(v1[0], v1[1]); w.w = cvt_pk_bf16(v1[2], v1[3]);
                    *(u32x4*)(rowp + bj * HALF) = w;
                    if (halo != nullptr && col0 >= halo_col0) {
                        const int rl = wr * 64 + fr + ai * HALF + m * 16;
                        const int hs = rl == 0 ? 0 : (rl == 1 ? 1 : (rl == 255 ? 2 : -1));
                        if (hs >= 0) *(u32x4*)(halo + ((size_t)u.pm * 3 + hs) * halo_ld + (col0 - halo_col0) + bj * HALF) = w;
                    } } }
    }
};
struct EpiSsdIn {
    static constexpr bool PERM = true;
    static constexpr bool STAGED = true, STAGED3 = false;
    bf16_t* O; bf16_t* halo; float* dt; RowMod rm;
    __device__ __forceinline__ const float* stage_src(const Unit& u, int tid) const { return rm.src(u, tid); }
    __device__ __forceinline__ void operator()(const f32x4 (&acc)[2][2][4][2], const Unit& u, int wr, int wc, int fr, int fq, const LAS float* slot) const {
        if (u.pn < 40) { EpiBf16 e{O, SSD_ZX, halo, SSD_DI, SSD_XBC, rm}; e(acc, u, wr, wc, fr, fq, slot); return; }
        const int row0 = u.pm * BM + wr * 64 + fr; const int col0 = wc * 32 + 8 * fq;
        float rs[2][4]; RowMod::rstd8(rs, slot, wr * 64 + fr); f32x4 bv[2][2]; RowMod::bias8(bv, slot, col0);
#pragma unroll
        for (int ai = 0; ai < 2; ++ai)
#pragma unroll
            for (int m = 0; m < 4; ++m) { float* rowp = dt + (size_t)(row0 + ai * HALF + m * 16) * 128 + col0;
                *(f32x4*)(rowp) = acc[ai][0][m][0] * rs[ai][m] + bv[0][0]; *(f32x4*)(rowp + 4) = acc[ai][0][m][1] * rs[ai][m] + bv[0][1]; }
    }
};
struct EpiSwiGLU {
    static constexpr bool PERM = true;
    static constexpr bool STAGED = true, STAGED3 = false;
    bf16_t* O; RowMod rm;
    __device__ __forceinline__ const float* stage_src(const Unit& u, int tid) const { return rm.src(u, tid); }
    __device__ __forceinline__ void operator()(const f32x4 (&acc)[2][2][4][2], const Unit& u, int wr, int wc, int fr, int fq, const LAS float* slot) const {
        const int row0 = u.pm * BM + wr * 64 + fr; const int col0 = u.pn * HALF + wc * 32 + 8 * fq;
        float rs[2][4]; RowMod::rstd8(rs, slot, wr * 64 + fr); f32x4 bv[2][2]; RowMod::bias8(bv, slot, wc * 32 + 8 * fq);
#pragma unroll
        for (int ai = 0; ai < 2; ++ai)
#pragma unroll
            for (int m = 0; m < 4; ++m) { bf16_t* rowp = O + (size_t)(row0 + ai * HALF + m * 16) * DFF + col0;
                float r[8];
#pragma unroll
                for (int n = 0; n < 2; ++n)
#pragma unroll
                    for (int e = 0; e < 4; ++e) r[n * 4 + e] = silu_f(acc[ai][0][m][n][e] * rs[ai][m] + bv[0][n][e]) * (acc[ai][1][m][n][e] * rs[ai][m] + bv[1][n][e]);
                u32x4 w; w.x = cvt_pk_bf16(r[0], r[1]); w.y = cvt_pk_bf16(r[2], r[3]); w.z = cvt_pk_bf16(r[4], r[5]); w.w = cvt_pk_bf16(r[6], r[7]);
                *(u32x4*)rowp = w; }
    }
};
template <bool XF32>
struct EpiResid {
    static constexpr bool PERM = true, STAGED = true, STAGED3 = true;
    const float* xin_p; const float* xin_s; bf16_t* x16; const float* gate;
    bf16_t* xg_in; bf16_t* xg_out; const float* gmv; const float* rgmv; float* rss_out;
    const float* rs_in; float rs_inv_n;
    __device__ __forceinline__ const float* stage_src(const Unit& u, int tid) const {
        const int ci = u.pm < 16 ? 8 : ((u.pm - 16) >> 4);
        const float* g = gate + (size_t)ci * 12288 + u.pn * BM;
        return tid < 256 ? g + tid : (xg_out != nullptr ? gmv + (size_t)ci * 2048 + u.pn * BM + (tid - 256) : g + (tid - 256));
    }
    __device__ __forceinline__ const float* stage_src3(const Unit& u, int tid) const {
        const int ci = u.pm < 16 ? 8 : ((u.pm - 16) >> 4);
        return XF32 ? gate + (size_t)ci * 12288 + u.pn * BM + tid : rgmv + (size_t)ci * 2048 + u.pn * BM + tid;
    }
    __device__ __forceinline__ void finish(const f32x4 (&nx)[2], float& ss, size_t ro, int bj, int row0, int cl0, const LAS float* slot) const {
        ss += (nx[0][0] * nx[0][0] + nx[0][1] * nx[0][1]) + (nx[0][2] * nx[0][2] + nx[0][3] * nx[0][3]);
        ss += (nx[1][0] * nx[1][0] + nx[1][1] * nx[1][1]) + (nx[1][2] * nx[1][2] + nx[1][3] * nx[1][3]);
        if (xg_out != nullptr) { const f32x4 a = nx[0] * *(const LAS f32x4*)(slot + 256 + cl0 + bj * HALF), b = nx[1] * *(const LAS f32x4*)(slot + 256 + cl0 + bj * HALF + 4);
            u32x4 w; w.x = cvt_pk_bf16(a[0], a[1]); w.y = cvt_pk_bf16(a[2], a[3]); w.z = cvt_pk_bf16(b[0], b[1]); w.w = cvt_pk_bf16(b[2], b[3]);
            *(u32x4*)(xg_out + (size_t)row0 * DM + ro + bj * HALF) = w; }
        else { u32x4 w16; w16.x = cvt_pk_bf16(nx[0][0], nx[0][1]); w16.y = cvt_pk_bf16(nx[0][2], nx[0][3]); w16.z = cvt_pk_bf16(nx[1][0], nx[1][1]); w16.w = cvt_pk_bf16(nx[1][2], nx[1][3]);
            *(u32x4*)(x16 + (size_t)row0 * DM + ro + bj * HALF) = w16; }
    }
    __device__ __forceinline__ void operator()(const f32x4 (&acc)[2][2][4][2], const Unit& u, int wr, int wc, int fr, int fq, const LAS float* slot) const {
        const int row0 = u.pm * BM + wr * 64 + fr, col0 = u.pn * BM + wc * 32 + 8 * fq, cl0 = wc * 32 + 8 * fq;
        float rsc[2][4];
#pragma unroll
        for (int ai = 0; ai < 2; ++ai)
#pragma unroll
            for (int m = 0; m < 4; ++m) rsc[ai][m] = rs_in ? 1.0f / sqrtf(rs_in[row0 + ai * HALF + m * 16] * rs_inv_n + EPS) : 1.0f;
        if constexpr (XF32) {
            const float* xi = (u.pm < 16) ? xin_p + (size_t)row0 * DM : xin_s + (size_t)(row0 - MP) * DM;
#pragma unroll
            for (int ai = 0; ai < 2; ++ai) {
                f32x4 xv[4][2][2];
#pragma unroll
                for (int m = 0; m < 4; ++m) { const size_t ro = (size_t)(ai * HALF + m * 16) * DM + col0;
#pragma unroll
                    for (int bj = 0; bj < 2; ++bj)
#pragma unroll
                        for (int n = 0; n < 2; ++n) xv[m][bj][n] = *(const f32x4*)(xi + ro + bj * HALF + n * 4); }
                asm volatile("" ::: "memory");
#pragma unroll
                for (int m = 0; m < 4; ++m) { const size_t ro = (size_t)(ai * HALF + m * 16) * DM + col0; float ss = 0.f;
#pragma unroll
                    for (int bj = 0; bj < 2; ++bj) { f32x4 nx[2];
#pragma unroll
                        for (int n = 0; n < 2; ++n) { const f32x4 gv = *(const LAS f32x4*)(slot + cl0 + bj * HALF + n * 4); nx[n] = xv[m][bj][n] + gv * (acc[ai][bj][m][n] * rsc[ai][m]); }
                        finish(nx, ss, ro, bj, row0, cl0, slot); }
                    ss += __shfl_xor(ss, 16); ss += __shfl_xor(ss, 32);
                    if (fq == 0) atomicAdd(rss_out + row0 + ai * HALF + m * 16, rintf(ss * 16.f) * 0.0625f); }
                asm volatile("" ::: "memory"); }
        } else {
            const bf16_t* xi = xg_in + (size_t)row0 * DM;
#pragma unroll
            for (int ai = 0; ai < 2; ++ai) {
                u32x4 xr[4][2];
#pragma unroll
                for (int m = 0; m < 4; ++m)
#pragma unroll
                    for (int bj = 0; bj < 2; ++bj) xr[m][bj] = *(const u32x4*)(xi + (size_t)(ai * HALF + m * 16) * DM + col0 + bj * HALF);
                asm volatile("" ::: "memory");
#pragma unroll
                for (int m = 0; m < 4; ++m) { const size_t ro = (size_t)(ai * HALF + m * 16) * DM + col0; float ss = 0.f;
#pragma unroll
                    for (int bj = 0; bj < 2; ++bj) { const u32x4 raw = xr[m][bj]; f32x4 nx[2];
                        const f32x4 x0 = {bf_lo(raw.x), bf_hi(raw.x), bf_lo(raw.y), bf_hi(raw.y)}, x1 = {bf_lo(raw.z), bf_hi(raw.z), bf_lo(raw.w), bf_hi(raw.w)};
                        nx[0] = x0 * *(const LAS f32x4*)(slot + 512 + cl0 + bj * HALF) + *(const LAS f32x4*)(slot + cl0 + bj * HALF) * (acc[ai][bj][m][0] * rsc[ai][m]);
                        nx[1] = x1 * *(const LAS f32x4*)(slot + 512 + cl0 + bj * HALF + 4) + *(const LAS f32x4*)(slot + cl0 + bj * HALF + 4) * (acc[ai][bj][m][1] * rsc[ai][m]);
                        finish(nx, ss, ro, bj, row0, cl0, slot); }
                    ss += __shfl_xor(ss, 16); ss += __shfl_xor(ss, 32);
                    if (fq == 0) atomicAdd(rss_out + row0 + ai * HALF + m * 16, rintf(ss * 16.f) * 0.0625f); }
                asm volatile("" ::: "memory"); }
        }
    }
};
}

namespace att {
constexpr int D = 128, NW = 8, QBLK = 32, KVBLK = 64;
constexpr float SCALE = 0.088388347648318440f;
constexpr float THR = 8.f;
constexpr int LDQ = NQKV, LDK = 512, LDV = NQKV, LDO = DM;
constexpr size_t SHM_V = KVBLK * D * 2, SHM_K = KVBLK * D * 2, SHM_ATTN = 2 * SHM_V + 2 * SHM_K + NW * 64 * 4;
#define KSWZ(row, colB) ((row) * 256 + ((colB) ^ (((row) & 7) << 4)))
#define SBAR() __builtin_amdgcn_sched_barrier(0)
__device__ __forceinline__ int crow(int r, int hi) { return (r & 3) + 8 * (r >> 2) + 4 * hi; }
__device__ __forceinline__ void partialSM(f32x16& p0, f32x16& p1, float& m_reg, float& mn, float& alpha) {
  constexpr float C = SCALE * 1.4426950408889634f;
  float pmax = p0[0]; for (int r = 1; r < 16; ++r) pmax = fmaxf(pmax, p0[r]); for (int r = 0; r < 16; ++r) pmax = fmaxf(pmax, p1[r]);
  { auto rr = __builtin_amdgcn_permlane32_swap(__float_as_uint(pmax), __float_as_uint(pmax), false, false);
    pmax = fmaxf(__uint_as_float(rr[0]), __uint_as_float(rr[1])); }
  if (__builtin_expect(__all(pmax - m_reg <= THR / SCALE), 1)) { mn = m_reg; alpha = 1.f; }
  else { mn = fmaxf(m_reg, pmax); alpha = __builtin_amdgcn_exp2f((m_reg - mn) * C); m_reg = mn; }
  float mnC = -mn * C;
  for (int r = 0; r < 16; ++r) p0[r] = fmaf(p0[r], C, mnC); for (int r = 0; r < 16; ++r) p1[r] = fmaf(p1[r], C, mnC);
  for (int r = 0; r < 16; ++r) p0[r] = __builtin_amdgcn_exp2f(p0[r]);
}
__device__ __forceinline__ void finishSM(f32x16& p0, f32x16& p1, float alpha, float& l_reg, bf16x8& pa0, bf16x8& pa1, bf16x8& pa2, bf16x8& pa3) {
  for (int r = 0; r < 16; ++r) p1[r] = __builtin_amdgcn_exp2f(p1[r]);
  f32x2 s2[8];
#pragma unroll
  for (int i = 0; i < 8; ++i) s2[i] = (f32x2){p0[2 * i], p0[2 * i + 1]} + (f32x2){p1[2 * i], p1[2 * i + 1]};
#pragma unroll
  for (int i = 0; i < 4; ++i) s2[i] += s2[i + 4];
  s2[0] += s2[2]; s2[1] += s2[3]; s2[0] += s2[1];
  float ps = s2[0].x + s2[0].y;
  { auto rr = __builtin_amdgcn_permlane32_swap(__float_as_uint(ps), __float_as_uint(ps), false, false);
    ps = __uint_as_float(rr[0]) + __uint_as_float(rr[1]); }
  l_reg = l_reg * alpha + ps;
#define PK4(P, BASE, OUT) do { unsigned a0 = cvt_pk_bf16(P[BASE + 0], P[BASE + 1]), a1 = cvt_pk_bf16(P[BASE + 2], P[BASE + 3]);   \
    unsigned b0 = cvt_pk_bf16(P[BASE + 4], P[BASE + 5]), b1 = cvt_pk_bf16(P[BASE + 6], P[BASE + 7]);                              \
    auto r0 = __builtin_amdgcn_permlane32_swap(a0, b0, false, false); auto r1 = __builtin_amdgcn_permlane32_swap(a1, b1, false, false); \
    u32x4 w = {r0[0], r1[0], r0[1], r1[1]}; OUT = *reinterpret_cast<bf16x8*>(&w); } while (0)
  PK4(p0, 0, pa0); PK4(p0, 8, pa1); PK4(p1, 0, pa2); PK4(p1, 8, pa3);
}
__device__ __forceinline__ void qkt(f32x16& p0, f32x16& p1, const bf16_t* Ks, const bf16x8* qr, int r32, int hi) {
  p0 = f32x16{}; p1 = f32x16{};
  for (int d0 = 0; d0 < 8; ++d0) { int cb = (d0 * 16 + hi * 8) * 2;
    bf16x8 b0 = *reinterpret_cast<const bf16x8*>((const char*)Ks + KSWZ(r32, cb));
    bf16x8 b1 = *reinterpret_cast<const bf16x8*>((const char*)Ks + KSWZ(32 + r32, cb));
    p0 = __builtin_amdgcn_mfma_f32_32x32x16_bf16(b0, qr[d0], p0, 0, 0, 0);
    p1 = __builtin_amdgcn_mfma_f32_32x32x16_bf16(b1, qr[d0], p1, 0, 0, 0); }
}
__device__ __forceinline__ int v_st(int k, int c) { const int kk = (k & ~0xC) | ((k & 4) << 1) | ((k & 8) >> 1); return ((kk >> 3) * 4 + (c >> 5)) * 512 + ((kk & 7) * 32 + (c & 31)) * 2; }
__device__ __forceinline__ int v_rd_base(int lane) { return ((lane & 3) << 3) | (((lane >> 2) & 3) << 6) | (((lane >> 4) & 1) << 5) | (((lane >> 5) & 1) << 8); }
constexpr int v_rd_off(int d0, int ks, int half) { return d0 * 512 + ks * 4096 + half * 2048; }
template <int OFF> __device__ __forceinline__ s16x4 tr_read(int vb) {
  s16x4 r; asm volatile("ds_read_b64_tr_b16 %0, %1 offset:%2" : "=&v"(r) : "v"(vb), "i"(OFF) : "memory"); return r;
}
template <int D0> __device__ __forceinline__ void pv_one(f32x16& od, int vb, bf16x8 pa0, bf16x8 pa1, bf16x8 pa2, bf16x8 pa3) {
  const s16x4 l0 = tr_read<v_rd_off(D0, 0, 0)>(vb), h0 = tr_read<v_rd_off(D0, 0, 1)>(vb), l1 = tr_read<v_rd_off(D0, 1, 0)>(vb), h1 = tr_read<v_rd_off(D0, 1, 1)>(vb);
  const s16x4 l2 = tr_read<v_rd_off(D0, 2, 0)>(vb), h2 = tr_read<v_rd_off(D0, 2, 1)>(vb), l3 = tr_read<v_rd_off(D0, 3, 0)>(vb), h3 = tr_read<v_rd_off(D0, 3, 1)>(vb);
  asm volatile("s_waitcnt lgkmcnt(0)" ::: "memory"); SBAR();
#define PK(L, H) (bf16x8){L[0], L[1], L[2], L[3], H[0], H[1], H[2], H[3]}
  od = __builtin_amdgcn_mfma_f32_32x32x16_bf16(pa0, PK(l0, h0), od, 0, 0, 0);
  od = __builtin_amdgcn_mfma_f32_32x32x16_bf16(pa1, PK(l1, h1), od, 0, 0, 0);
  od = __builtin_amdgcn_mfma_f32_32x32x16_bf16(pa2, PK(l2, h2), od, 0, 0, 0);
  od = __builtin_amdgcn_mfma_f32_32x32x16_bf16(pa3, PK(l3, h3), od, 0, 0, 0);
#undef PK
}
__device__ __forceinline__ void pv_d0(f32x16* o, int vb, bf16x8 pa0, bf16x8 pa1, bf16x8 pa2, bf16x8 pa3) {
  pv_one<0>(o[0], vb, pa0, pa1, pa2, pa3); pv_one<1>(o[1], vb, pa0, pa1, pa2, pa3); pv_one<2>(o[2], vb, pa0, pa1, pa2, pa3); pv_one<3>(o[3], vb, pa0, pa1, pa2, pa3);
}
__device__ __forceinline__ void attn_dense_body(const bf16_t* __restrict__ Qb, const bf16_t* __restrict__ Kh, const bf16_t* __restrict__ Vh,
                                                bf16_t* __restrict__ Ob, int seq, char* lds, const int wv_) {
  constexpr int SDEPTH = 2;
  const int tid = opaque_tid(wv_), wid = tid >> 6, lane = tid & 63, r32 = lane & 31, hi = lane >> 5;
  bf16_t* V_lds = (bf16_t*)lds; bf16_t* K_lds = (bf16_t*)(lds + 2 * SHM_V);
  float* ws = (float*)(lds + 2 * SHM_V + 2 * SHM_K) + wid * 64; float* li_l = ws; float* al_l = ws + 32;
  float m_reg = -1e30f, l_reg = 0; f32x16 o[4] = {}; bf16x8 qr[8];
  const bf16_t* Qw = Qb + (long)(wid * QBLK + r32) * LDQ + hi * 8;
#pragma unroll
  for (int d0 = 0; d0 < 8; ++d0) qr[d0] = *reinterpret_cast<const bf16x8*>(Qw + d0 * 16);
  const int sr = tid >> 4, sc = (tid & 15) * 8, vst0 = v_st(sr, sc), vst1 = v_st(32 + sr, sc);
  const int vb0 = (int)(uintptr_t)V_lds + v_rd_base(lane);
  struct { bf16x8 vs0, vs1, ks0, ks1; } sr_[SDEPTH];
#define LD8(p) (*reinterpret_cast<const bf16x8*>(p))
#define SLOAD(i, k0) do { sr_[i].vs0 = LD8(&Vh[(long)((k0) + sr) * LDK + sc]); sr_[i].vs1 = LD8(&Vh[(long)((k0) + 32 + sr) * LDK + sc]); \
    sr_[i].ks0 = LD8(&Kh[(long)((k0) + sr) * LDK + sc]); sr_[i].ks1 = LD8(&Kh[(long)((k0) + 32 + sr) * LDK + sc]); } while (0)
#define SWRITE(b, i) do { *(bf16x8*)((char*)V_lds + (b) * SHM_V + vst0) = sr_[i].vs0;          \
    *(bf16x8*)((char*)V_lds + (b) * SHM_V + vst1) = sr_[i].vs1; int kc = sc * 2;               \
    *(bf16x8*)((char*)K_lds + (b) * SHM_K + KSWZ(sr, kc)) = sr_[i].ks0;                       \
    *(bf16x8*)((char*)K_lds + (b) * SHM_K + KSWZ(32 + sr, kc)) = sr_[i].ks1; } while (0)
#define SWAIT() do { asm volatile("s_waitcnt vmcnt(4)" ::: "memory"); } while (0)
#define RESC(a) do { if (__any((a) < 1.f)) { if (hi == 0) al_l[r32] = (a); asm volatile("s_waitcnt lgkmcnt(0)" ::: "memory"); \
    for (int d = 0; d < 4; ++d) for (int r = 0; r < 16; ++r) o[d][r] *= al_l[crow(r, hi)]; } } while (0)
  f32x16 pA0, pA1, pB0, pB1; float mnA, mnB, alA, alB; bf16x8 pa0, pa1, pa2, pa3; const int NT = seq / KVBLK;
  constexpr int SE = 0, SO = SDEPTH - 1;
  SLOAD(SE, 0); asm volatile("s_waitcnt vmcnt(0)" ::: "memory"); SWRITE(0, SE); __syncthreads();
  qkt(pA0, pA1, K_lds, qr, r32, hi); partialSM(pA0, pA1, m_reg, mnA, alA);
  SLOAD(SO, KVBLK); if (2 < NT) SLOAD(SE, 2 * KVBLK);
  SWAIT(); SWRITE(1, SO); __syncthreads();
  for (int j = 1; j + 1 < NT; j += 2) {
    SBAR(); qkt(pB0, pB1, (bf16_t*)((char*)K_lds + SHM_K), qr, r32, hi);
    finishSM(pA0, pA1, alA, l_reg, pa0, pa1, pa2, pa3); SBAR();
    SLOAD(SO, (j + SDEPTH) * KVBLK); SBAR();
    pv_d0(o, vb0, pa0, pa1, pa2, pa3); partialSM(pB0, pB1, m_reg, mnB, alB);
    __syncthreads(); SWAIT(); SWRITE(0, SE);
    RESC(alB); __syncthreads();
    SBAR(); qkt(pA0, pA1, K_lds, qr, r32, hi);
    finishSM(pB0, pB1, alB, l_reg, pa0, pa1, pa2, pa3); SBAR();
    if (j + 3 < NT) SLOAD(SE, (j + 1 + SDEPTH) * KVBLK); SBAR();
    pv_d0(o, vb0 + (int)SHM_V, pa0, pa1, pa2, pa3); partialSM(pA0, pA1, m_reg, mnA, alA);
    __syncthreads(); SWAIT(); SWRITE(1, SO);
    RESC(alA); __syncthreads();
  }
  SBAR(); qkt(pB0, pB1, (bf16_t*)((char*)K_lds + SHM_K), qr, r32, hi);
  finishSM(pA0, pA1, alA, l_reg, pa0, pa1, pa2, pa3); SBAR();
  pv_d0(o, vb0, pa0, pa1, pa2, pa3); partialSM(pB0, pB1, m_reg, mnB, alB);
  __syncthreads(); RESC(alB);
  finishSM(pB0, pB1, alB, l_reg, pa0, pa1, pa2, pa3); SBAR();
  pv_d0(o, vb0 + (int)SHM_V, pa0, pa1, pa2, pa3);
  if (hi == 0) li_l[r32] = l_reg; asm volatile("s_waitcnt lgkmcnt(0)" ::: "memory");
  float rli[16];
#pragma unroll
  for (int r = 0; r < 16; ++r) rli[r] = __builtin_amdgcn_rcpf(li_l[crow(r, hi)]);
  bf16_t* Ow = Ob + (long)(wid * QBLK) * LDO;
#pragma unroll
  for (int r = 0; r < 16; ++r) { int orow = crow(r, hi);
    for (int d0 = 0; d0 < 4; ++d0) Ow[(long)orow * LDO + d0 * 32 + r32] = (bf16_t)(cvt_pk_bf16(o[d0][r] * rli[r], 0.f) & 0xffffu); }
  asm volatile("s_waitcnt vmcnt(0)" ::: "memory");
  __syncthreads();
#undef LD8
#undef SLOAD
#undef SWRITE
#undef SWAIT
#undef RESC
}

constexpr unsigned ASLOT = 32768u, AOFF_V = 16384u, AOFF_WS = RING_BYTES + 8192;
constexpr float C_L2 = SCALE * 1.4426950408889634f, THR_L2 = THR * 1.4426950408889634f;
template <bool FIRST>
__device__ __forceinline__ void partialSM2(f32x16& p0, f32x16& p1, f32x16& negm, float& alpha) {
  float pmax = p0[0]; for (int r = 1; r < 16; ++r) pmax = fmaxf(pmax, p0[r]); for (int r = 0; r < 16; ++r) pmax = fmaxf(pmax, p1[r]);
  { auto rr = __builtin_amdgcn_permlane32_swap(__float_as_uint(pmax), __float_as_uint(pmax), false, false);
    pmax = fmaxf(__uint_as_float(rr[0]), __uint_as_float(rr[1])); }
  if (FIRST) { alpha = 1.f; for (int r = 0; r < 16; ++r) { p0[r] -= pmax; p1[r] -= pmax; negm[r] = -pmax; } }
  else if (__builtin_expect(__all(pmax <= THR_L2), 1)) { alpha = 1.f; }
  else { const float d = fmaxf(pmax, 0.f); alpha = __builtin_amdgcn_exp2f(-d); for (int r = 0; r < 16; ++r) { p0[r] -= d; p1[r] -= d; negm[r] -= d; } }
  for (int r = 0; r < 16; ++r) p0[r] = __builtin_amdgcn_exp2f(p0[r]);
}
__device__ __forceinline__ void qkt2(f32x16& p0, f32x16& p1, const f32x16& negm, LAS const unsigned char* kb, unsigned kl, const bf16x8* qr) {
#pragma unroll
  for (int d0 = 0; d0 < 8; ++d0) { const unsigned a = kl ^ (32u * d0);
    const bf16x8 b0 = *(LAS const bf16x8*)(kb + a), b1 = *(LAS const bf16x8*)(kb + a + 8192);
    if (d0 == 0) { p0 = __builtin_amdgcn_mfma_f32_32x32x16_bf16(b0, qr[0], negm, 0, 0, 0); p1 = __builtin_amdgcn_mfma_f32_32x32x16_bf16(b1, qr[0], negm, 0, 0, 0); }
    else { p0 = __builtin_amdgcn_mfma_f32_32x32x16_bf16(b0, qr[d0], p0, 0, 0, 0); p1 = __builtin_amdgcn_mfma_f32_32x32x16_bf16(b1, qr[d0], p1, 0, 0, 0); } }
}
__device__ __forceinline__ void attn_dma_body(const bf16_t* __restrict__ Qb, const bf16_t* __restrict__ Kh, const bf16_t* __restrict__ Vh,
                                              bf16_t* __restrict__ Ob, int seq, LAS unsigned char* lds, const int wv_, const float* __restrict__ qnw, const f32x2* __restrict__ rope, const int tok0,
                                              const bf16_t* __restrict__ Vc, const int nown) {
  const int tid = opaque_tid(wv_), wid = __builtin_amdgcn_readfirstlane(tid >> 6), lane = tid & 63, r32 = lane & 31, hi = lane >> 5;
  LAS float* wsl = (LAS float*)(lds + AOFF_WS) + wid * 64; LAS float* li_l = wsl; LAS float* al_l = wsl + 32;
  f32x16 o[4] = {}; f32x16 negm = {}; float l_reg = 0; bf16x8 qr[8];
  const int NT = seq / KVBLK;
  unsigned kof[2], vof[2];
#pragma unroll
  for (int i = 0; i < 2; ++i) { const int row = 4 * (2 * wid + i) + (lane >> 4), ch = (lane & 15) ^ (row & 7); kof[i] = (unsigned)(row * LDK + ch * 8) * 2u;
    const int kk = 8 * wid + ((lane & 31) >> 2), k = (kk & ~0xC) | ((kk & 4) << 1) | ((kk & 8) >> 1), c = (2 * i + (lane >> 5)) * 32 + (lane & 3) * 8; vof[i] = (unsigned)(k * LDV + c) * 2u; }
#define ADMA(t) do { const unsigned so_ = ((unsigned)(t) & 3u) * ASLOT + (unsigned)wid * 2048u; const char* kg_ = (const char*)Kh + (size_t)(t) * (KVBLK * LDK * 2); const char* vg_ = ((t) < nown) ? (const char*)Vh + (size_t)(t) * (KVBLK * LDV * 2) : (const char*)Vc + (size_t)((t) - nown) * (KVBLK * LDV * 2); \
    _Pragma("unroll") for (int i_ = 0; i_ < 2; ++i_) { unsigned ko_ = kof[i_], vo_ = vof[i_]; asm volatile("" : "+v"(ko_), "+v"(vo_)); \
      __builtin_amdgcn_global_load_lds((const unsigned*)(kg_ + ko_), (LAS unsigned*)(lds + so_ + i_ * 1024), 16, 0, 0); \
      __builtin_amdgcn_global_load_lds((const unsigned*)(vg_ + vo_), (LAS unsigned*)(lds + so_ + AOFF_V + i_ * 1024), 16, 0, 0); } } while (0)
#define AWAITV(n) asm volatile("s_waitcnt vmcnt(" #n ")" ::: "memory")
#define ABAR() do { asm volatile("" ::: "memory"); __builtin_amdgcn_s_barrier(); asm volatile("" ::: "memory"); } while (0)
  const bf16_t* Qw = Qb + (long)(wid * QBLK + r32) * LDQ + hi * 8;
#pragma unroll
  for (int d0 = 0; d0 < 8; ++d0) qr[d0] = *reinterpret_cast<const bf16x8*>(Qw + d0 * 16);
  f32x4 qw4[16], rp4[16];
  { const int t = (tok0 < 0 ? 0 : tok0) + wid * QBLK + r32;
#pragma unroll
    for (int h2 = 0; h2 < 2; ++h2)
#pragma unroll
      for (int d0 = 0; d0 < 4; ++d0)
#pragma unroll
        for (int j = 0; j < 2; ++j) qw4[(h2 * 4 + d0) * 2 + j] = *(const f32x4*)(qnw + h2 * 64 + d0 * 16 + hi * 8 + 4 * j);
#pragma unroll
    for (int d0 = 0; d0 < 4; ++d0) { const f32x4* rp = (const f32x4*)(rope + ((d0 < 2) ? (t >> 6) : (t & 63)) * 32 + (d0 & 1) * 16 + hi * 8);
#pragma unroll
      for (int j = 0; j < 4; ++j) rp4[d0 * 4 + j] = rp[j]; } }
  asm volatile("" ::: "memory");
  ADMA(0); ADMA(1); ADMA(2);
  {
    float ss = 0.f;
#pragma unroll
    for (int d0 = 0; d0 < 8; ++d0)
#pragma unroll
      for (int e = 0; e < 8; ++e) { const float x = __uint_as_float(((unsigned)(unsigned short)qr[d0][e]) << 16); ss += x * x; }
    { auto rr = __builtin_amdgcn_permlane32_swap(__float_as_uint(ss), __float_as_uint(ss), false, false); ss = __uint_as_float(rr[0]) + __uint_as_float(rr[1]); }
    const float rstd = 1.0f / sqrtf(ss * (1.0f / 128.0f) + EPS);
#pragma unroll
    for (int d0 = 0; d0 < 4; ++d0) {
      float a[8], b[8];
#pragma unroll
      for (int e = 0; e < 8; ++e) { const float wa = qw4[d0 * 2 + (e >> 2)][e & 3] * C_L2, wb = qw4[(4 + d0) * 2 + (e >> 2)][e & 3] * C_L2;
        a[e] = __uint_as_float(((unsigned)(unsigned short)qr[d0][e]) << 16) * rstd * wa; b[e] = __uint_as_float(((unsigned)(unsigned short)qr[d0 + 4][e]) << 16) * rstd * wb; }
      if (tok0 >= 0) {
#pragma unroll
        for (int e = 0; e < 8; ++e) { const float c_ = rp4[d0 * 4 + (e >> 1)][(e & 1) * 2], s_ = rp4[d0 * 4 + (e >> 1)][(e & 1) * 2 + 1]; const float x = a[e], y = b[e]; a[e] = x * c_ - y * s_; b[e] = y * c_ + x * s_; } }
      u32x4 wa_, wb_;
      wa_.x = cvt_pk_bf16(a[0], a[1]); wa_.y = cvt_pk_bf16(a[2], a[3]); wa_.z = cvt_pk_bf16(a[4], a[5]); wa_.w = cvt_pk_bf16(a[6], a[7]);
      wb_.x = cvt_pk_bf16(b[0], b[1]); wb_.y = cvt_pk_bf16(b[2], b[3]); wb_.z = cvt_pk_bf16(b[4], b[5]); wb_.w = cvt_pk_bf16(b[6], b[7]);
      qr[d0] = *reinterpret_cast<bf16x8*>(&wa_); qr[d0 + 4] = *reinterpret_cast<bf16x8*>(&wb_); }
  }
  const unsigned kl = 256u * (unsigned)r32 + ((((unsigned)hi) ^ ((unsigned)r32 & 7u)) << 4);
  const unsigned vb0 = (unsigned)(uintptr_t)lds + AOFF_V + (unsigned)v_rd_base(lane);
#define KSL(t) (lds + ((unsigned)(t) & 3u) * ASLOT)
#define VSL(t) ((int)(vb0 + ((unsigned)(t) & 3u) * ASLOT))
#define RESC2(a) do { if (__any((a) < 1.f)) { if (hi == 0) al_l[r32] = (a); asm volatile("s_waitcnt lgkmcnt(0)" ::: "memory"); \
    for (int d = 0; d < 4; ++d) for (int r = 0; r < 16; ++r) o[d][r] *= al_l[crow(r, hi)]; } } while (0)
#define ASTEP_END(s) do { if ((s) + 2 < NT) AWAITV(4); else AWAITV(0); ABAR(); if ((s) + 3 < NT) ADMA((s) + 3); } while (0)
  f32x16 pA0, pA1, pB0, pB1; float alA, alB; bf16x8 pa0, pa1, pa2, pa3;
  AWAITV(8); ABAR();
  qkt2(pA0, pA1, negm, KSL(0), kl, qr); partialSM2<true>(pA0, pA1, negm, alA);
  ASTEP_END(0);
  for (int j = 1; j + 1 < NT; j += 2) {
    SBAR(); qkt2(pB0, pB1, negm, KSL(j), kl, qr);
    finishSM(pA0, pA1, alA, l_reg, pa0, pa1, pa2, pa3); SBAR();
    pv_d0(o, VSL(j - 1), pa0, pa1, pa2, pa3); partialSM2<false>(pB0, pB1, negm, alB);
    RESC2(alB); ASTEP_END(j);
    SBAR(); qkt2(pA0, pA1, negm, KSL(j + 1), kl, qr);
    finishSM(pB0, pB1, alB, l_reg, pa0, pa1, pa2, pa3); SBAR();
    pv_d0(o, VSL(j), pa0, pa1, pa2, pa3); partialSM2<false>(pA0, pA1, negm, alA);
    RESC2(alA); ASTEP_END(j + 1);
  }
  SBAR(); qkt2(pB0, pB1, negm, KSL(NT - 1), kl, qr);
  finishSM(pA0, pA1, alA, l_reg, pa0, pa1, pa2, pa3); SBAR();
  pv_d0(o, VSL(NT - 2), pa0, pa1, pa2, pa3); partialSM2<false>(pB0, pB1, negm, alB);
  RESC2(alB);
  finishSM(pB0, pB1, alB, l_reg, pa0, pa1, pa2, pa3); SBAR();
  pv_d0(o, VSL(NT - 1), pa0, pa1, pa2, pa3);
  if (hi == 0) li_l[r32] = l_reg; asm volatile("s_waitcnt lgkmcnt(0)" ::: "memory");
  ABAR();
  float rli[16];
#pragma unroll
  for (int r = 0; r < 16; ++r) rli[r] = __builtin_amdgcn_rcpf(li_l[crow(r, hi)]);
  bf16_t* Ow = Ob + (long)(wid * QBLK) * LDO;
#pragma unroll
  for (int r = 0; r < 16; ++r) { int orow = crow(r, hi);
    for (int d0 = 0; d0 < 4; ++d0) Ow[(long)orow * LDO + d0 * 32 + r32] = (bf16_t)(cvt_pk_bf16(o[d0][r] * rli[r], 0.f) & 0xffffu); }
  asm volatile("s_waitcnt lgkmcnt(0)" ::: "memory");
#undef ADMA
#undef AWAITV
#undef ABAR
#undef KSL
#undef VSL
#undef RESC2
#undef ASTEP_END
}
}

__device__ __forceinline__ void tr_item(const float* W, int ldw, int K, bf16_t* WT, int k0, int nd0, int ns0, LAS float* scr, int lane) {
    if (ns0 >= 0) {
#pragma unroll
        for (int i = 0; i < 32; ++i) { const int kk = 2 * i + (lane >> 5); scr[kk * 33 + (lane & 31)] = W[(size_t)(k0 + kk) * ldw + ns0 + (lane & 31)]; }
    } else {
#pragma unroll 8
        for (int i = 0; i < 32; ++i) { const int kk = 2 * i + (lane >> 5); scr[kk * 33 + (lane & 31)] = 0.f; }
    }
    LDS_WAIT(); asm volatile("" ::: "memory");
    const int c = lane & 7;
#pragma unroll
    for (int j = 0; j < 4; ++j) { const int n = (lane >> 3) + 8 * j; const LAS float* s = scr + (8 * c) * 33 + n;
        u32x4 o; o.x = cvt_pk_bf16(s[0 * 33], s[1 * 33]); o.y = cvt_pk_bf16(s[2 * 33], s[3 * 33]); o.z = cvt_pk_bf16(s[4 * 33], s[5 * 33]); o.w = cvt_pk_bf16(s[6 * 33], s[7 * 33]);
        *(u32x4*)(WT + (size_t)(nd0 + n) * K + k0 + 8 * c) = o; }
    LDS_WAIT(); asm volatile("" ::: "memory");
}
template <int MAP>
__device__ __forceinline__ void transpose_mat(const float* W, int ldw, int K, bf16_t* WT, int Ndst, LAS float* scr, int gw, int NGW, int lane, int& off) {
    const int nblk = Ndst / 32, nitems = (K / 64) * nblk;
    const int it0 = (gw + NGW - off % NGW) % NGW; off += nitems;
    for (int it = it0; it < nitems; it += NGW) {
        const int kb = it / nblk, nb = it % nblk, nd0 = nb * 32; int ns0 = nd0;
        if (MAP == 1) { const int pn = nd0 >> 8, r = nd0 & 255; ns0 = (r < 128) ? pn * 128 + r : DFF + pn * 128 + (r - 128); }
        if (MAP == 2) { if (nd0 >= 10368) ns0 = -1; }
        tr_item(W, ldw, K, WT, kb * 64, nd0, ns0, scr, lane);
    }
}

__device__ __forceinline__ void xg_init_pass(const float* xp, const float* xs, const float* gain, const float* mod, int sc_off, bf16_t* XG, float* rss, int gw, int NGW, int lane) {
    for (int row = gw; row < MT; row += NGW) {
        const float* xr = row < MP ? xp + (size_t)row * DM : xs + (size_t)(row - MP) * DM;
        const int ci = row < MP ? 8 : ((row - MP) >> 12);
        const float* mrow = mod + (size_t)ci * 12288;
        const f32x4* x4 = (const f32x4*)xr + lane;
        f32x4 v[8]; float ss = 0.f;
#pragma unroll
        for (int j = 0; j < 8; ++j) { v[j] = x4[64 * j]; ss += (v[j].x * v[j].x + v[j].y * v[j].y) + (v[j].z * v[j].z + v[j].w * v[j].w); }
        ss = wave_sum(ss);
        if (lane == 0) rss[row] = ss;
        u32x2* o8 = (u32x2*)(XG + (size_t)row * DM) + lane;
#pragma unroll
        for (int j = 0; j < 8; ++j) {
            const f32x4 g = ((const f32x4*)gain)[64 * j + lane], sc = ((const f32x4*)(mrow + sc_off))[64 * j + lane];
            const f32x4 r = v[j] * g * (sc + 1.0f);
            u32x2 w; w.x = cvt_pk_bf16(r.x, r.y); w.y = cvt_pk_bf16(r.z, r.w); o8[64 * j] = w; }
    }
}
__device__ __forceinline__ void bias_mat(LAS unsigned char* lds, const bf16_t* Wt, int N, const float* shbase, float* bias, int gw, int NGW, int tid, int lane, int off = 0) {
    __syncthreads();
    for (int i = tid; i < 16 * 256; i += NTHREADS) {
        const int ci = i >> 8, ch = i & 255; u32x4 w = {0u, 0u, 0u, 0u};
        if (ci < 9) { const float* p = shbase + (size_t)ci * 12288 + ch * 8; const f32x4 a = *(const f32x4*)p, c = *(const f32x4*)(p + 4);
            w.x = cvt_pk_bf16(a.x, a.y); w.y = cvt_pk_bf16(a.z, a.w); w.z = cvt_pk_bf16(c.x, c.y); w.w = cvt_pk_bf16(c.z, c.w); }
        *(LAS u32x4*)(lds + ci * 4096 + 16 * (ch ^ ci)) = w; }
    __syncthreads();
    const int ci = lane & 15, q = lane >> 4;
    for (int t = (gw + NGW - off % NGW) % NGW; t < N / 16; t += NGW) {
        const bf16_t* wrow = Wt + (size_t)(16 * t + ci) * DM + 8 * q;
        f32x4 acc = {0.f, 0.f, 0.f, 0.f};
#pragma unroll 8
        for (int s_ = 0; s_ < 64; ++s_) {
            const bf16x8 bf = *(const bf16x8*)(wrow + 32 * s_);
            const bf16x8 af = *(const LAS bf16x8*)(lds + ci * 4096 + 16 * ((4 * s_ + q) ^ ci));
            acc = __builtin_amdgcn_mfma_f32_16x16x32_bf16(af, bf, acc, 0, 0, 0); }
#pragma unroll
        for (int r = 0; r < 4; ++r) { const int c = 4 * q + r; if (c < 9) bias[(size_t)c * N + 16 * t + ci] = acc[r]; }
    }
}

__device__ __forceinline__ unsigned img_off(unsigned row, unsigned ch) { return 256u * row + 16u * (ch ^ (((row & 3) << 2) | ((row >> 2) & 3))); }
__device__ __forceinline__ unsigned img_row_addr(unsigned lane, unsigned rb, unsigned s) { return img_off(32 * rb + (lane & 31), 2 * s + (lane >> 5)); }
__device__ __forceinline__ unsigned img_tr_addr(unsigned lane, unsigned c, unsigned ks, unsigned t) {
    const unsigned h = lane >> 5, blk = (lane >> 4) & 1, q = (lane & 15) >> 2, p = lane & 3;
    return img_off(16 * ks + 8 * h + 4 * t + q, 4 * c + 2 * blk + (p >> 1)) + 8 * (p & 1);
}
__device__ __forceinline__ unsigned img_row_addr16(unsigned lane, unsigned rb, unsigned s) { return img_off((lane & 15) + 16 * rb, 4 * s + (lane >> 4)); }
__device__ __forceinline__ s16x4 ds_tr_read(unsigned addr) { s16x4 r; asm volatile("ds_read_b64_tr_b16 %0, %1" : "=&v"(r) : "v"(addr) : "memory"); return r; }
__device__ __forceinline__ int crow32(int r, int hi) { return (r & 3) + 8 * (r >> 2) + 4 * hi; }
#define PK4X(P, BASE, OUT) do { unsigned a0_ = cvt_pk_bf16(P[BASE + 0], P[BASE + 1]), a1_ = cvt_pk_bf16(P[BASE + 2], P[BASE + 3]);   \
    unsigned b0_ = cvt_pk_bf16(P[BASE + 4], P[BASE + 5]), b1_ = cvt_pk_bf16(P[BASE + 6], P[BASE + 7]);                              \
    auto r0_ = __builtin_amdgcn_permlane32_swap(a0_, b0_, false, false); auto r1_ = __builtin_amdgcn_permlane32_swap(a1_, b1_, false, false); \
    u32x4 w_ = {r0_[0], r1_[0], r0_[1], r1_[1]}; OUT = *reinterpret_cast<bf16x8*>(&w_); } while (0)

template <bool SILU>
__device__ __forceinline__ void conv_inplace(bf16_t* buf, int ld, int col0, int ncols, const bf16_t* halo, const float* cw, const float* cb, int gtid, int gthreads) {
    const int ngrp = ncols / 8, nitems = 144 * ngrp;
    for (int it = gtid; it < nitems; it += gthreads) {
        const int pm = it / ngrp, cg = it % ngrp, c = cg * 8;
        const bool first = pm < 16 ? true : (((pm - 16) & 15) == 0), last = pm < 16 ? true : (((pm - 16) & 15) == 15);
        float w0[8], w1[8], w2[8], w3[8], bs[8];
#pragma unroll
        for (int e = 0; e < 8; ++e) { w0[e] = cw[c + e]; w1[e] = cw[ncols + c + e]; w2[e] = cw[2 * ncols + c + e]; w3[e] = cw[3 * ncols + c + e]; bs[e] = cb[c + e]; }
        bf16_t* base = buf + (size_t)pm * 256 * ld + col0 + c;
        const u32x4 zero = {0u, 0u, 0u, 0u};
        u32x4 rm1 = first ? zero : *(const u32x4*)(halo + ((size_t)(pm - 1) * 3 + 2) * ncols + c);
        u32x4 r0 = *(const u32x4*)(base), r1 = *(const u32x4*)(base + ld);
        const u32x4 n0 = last ? zero : *(const u32x4*)(halo + ((size_t)(pm + 1) * 3 + 0) * ncols + c);
        const u32x4 n1 = last ? zero : *(const u32x4*)(halo + ((size_t)(pm + 1) * 3 + 1) * ncols + c);
#define CV_UNPACK(v, f) do { f[0] = bf_lo(v.x); f[1] = bf_hi(v.x); f[2] = bf_lo(v.y); f[3] = bf_hi(v.y); f[4] = bf_lo(v.z); f[5] = bf_hi(v.z); f[6] = bf_lo(v.w); f[7] = bf_hi(v.w); } while (0)
        for (int t = 0; t < 256; t += 8) {
            u32x4 q[11];
            q[0] = rm1; q[1] = r0; q[2] = r1;
#pragma unroll
            for (int k = 0; k < 8; ++k) { const int rr = t + 2 + k; q[3 + k] = rr < 256 ? *(const u32x4*)(base + (size_t)rr * ld) : (rr == 256 ? n0 : n1); }
            asm volatile("" ::: "memory");
#pragma unroll
            for (int k = 0; k < 8; ++k) {
                float a[8], b[8], cc[8], d[8], o[8];
                CV_UNPACK(q[k], a); CV_UNPACK(q[k + 1], b); CV_UNPACK(q[k + 2], cc); CV_UNPACK(q[k + 3], d);
#pragma unroll
                for (int e = 0; e < 8; ++e) { float v = bs[e] + w0[e] * a[e] + w1[e] * b[e] + w2[e] * cc[e] + w3[e] * d[e]; o[e] = SILU ? silu_f(v) : v; }
                u32x4 w; w.x = cvt_pk_bf16(o[0], o[1]); w.y = cvt_pk_bf16(o[2], o[3]); w.z = cvt_pk_bf16(o[4], o[5]); w.w = cvt_pk_bf16(o[6], o[7]);
                *(u32x4*)(base + (size_t)(t + k) * ld) = w;
            }
            rm1 = q[8]; r0 = q[9]; r1 = q[10];
        }
#undef CV_UNPACK
    }
}

namespace ssd {
constexpr int OFF_B = 0  , OFF_X = 65536, OFF_S = 98304, OFF_SM = 132096;
constexpr int SM_CUM = 0, SM_ECUM = 128, SM_WST = 256, SM_DT = 384, SM_HEAD = 512, SM_TOT = 1024;
__device__ __forceinline__ void scan_unit(LAS unsigned char* lds, bf16_t* zx, const float* dtraw, bf16_t* Y, const float* dt_bias, const float* a_log, const float* d_skip, const float* nw, float* rss9,
                                          const float* s0  , float* sT  , int row_base, int nchunks, int hp, const int wv_) {
    const int tid = opaque_tid(wv_), lane = tid & 63, wid = __builtin_amdgcn_readfirstlane(tid >> 6), hd = wid >> 2, ib = hd ? 3 - (wid & 3) : (wid & 3), r32 = lane & 31, hi = lane >> 5;
    const int head = 2 * hp + hd, grp = hp >> 2;
    LAS float* sm = (LAS float*)(lds + OFF_SM);
    LAS float* smh = sm + hd * SM_HEAD;
    const float dsk = d_skip[head];
    const unsigned ldsb = (unsigned)(uintptr_t)lds;
    constexpr int SM_NW = 1280;
    __syncthreads();
    if (tid < 128) sm[SM_NW + tid] = nw[hp * 128 + tid];
    unsigned RA0, TA0, EA0;
    { const unsigned fl = ((r32 & 3) << 2) | ((r32 >> 2) & 3); RA0 = 256u * r32 + 16u * ((unsigned)hi ^ fl);
      const unsigned blk = (lane >> 4) & 1, q = (lane & 15) >> 2, p = lane & 3; const unsigned L1 = 4 * q + 2 * (blk ^ (unsigned)hi) + (p >> 1); TA0 = 256u * (8 * hi + q) + 16u * L1 + 8u * (p & 1);
      EA0 = 1024u * hi + 16u * (((unsigned)r32 >> 3) ^ (unsigned)hi) + 2u * (r32 & 7); }
#define FR_(r) (4 * ((r) & 3) + 2 * (((r) >> 2) & 1))
#define ROWC_(r) (256 * (((r) & 3) + 8 * ((r) >> 2)))
#define SSD_DMA_B(rowN, bufsel) do { _Pragma("unroll") for (int q_ = 0; q_ < 4; ++q_) { const int i_ = wid * 4 + q_; const int row_ = 4 * i_ + (lane_c >> 4); \
        const int ch_ = (lane_c & 15) ^ ((((lane_c >> 4) & 3) << 2) | (i_ & 3)); \
        __builtin_amdgcn_global_load_lds((const unsigned*)(zx + (size_t)((rowN) + row_) * SSD_ZX + 8192 + grp * 128 + ch_ * 8), (LAS unsigned*)(lds + OFF_B + (bufsel) * 32768 + 1024 * i_), 16, 0, 0); } } while (0)
#define SSD_LOAD_X(dst, rowN) do { _Pragma("unroll") for (int q_ = 0; q_ < 4; ++q_) { const int idx_ = tid_c + 512 * q_; dst[q_] = *(const u32x4*)(zx + (size_t)((rowN) + (idx_ >> 4)) * SSD_ZX + 4096 + hp * 128 + (idx_ & 15) * 8); } } while (0)
#define SSD_STORE_X(src) do { _Pragma("unroll") for (int q_ = 0; q_ < 4; ++q_) { const int idx_ = tid_c + 512 * q_; *(LAS u32x4*)(lds + OFF_X + img_off(idx_ >> 4, idx_ & 15)) = src[q_]; } } while (0)
#define SSD_LOAD_C(rowN) do { const bf16_t* cp_ = zx + (size_t)((rowN) + 32 * ib + r32) * SSD_ZX + 9216 + grp * 128 + 8 * hi; _Pragma("unroll") for (int s_ = 0; s_ < 8; ++s_) cf[s_] = *(const bf16x8*)(cp_ + 16 * s_); } while (0)
#define SSD_DT_ARRAYS(x0_, x1_) do { const int hh_ = 2 * hp + wid; const float An_ = -__expf(a_log[dir * 64 + hh_]); \
        const float d0_ = (x0_) > 20.f ? (x0_) : log1pf(__expf(x0_)), d1_ = (x1_) > 20.f ? (x1_) : log1pf(__expf(x1_)); const float a0_ = d0_ * An_, a1_ = d1_ * An_; \
        float P_ = a0_ + a1_; _Pragma("unroll") for (int o_ = 1; o_ < 64; o_ <<= 1) { const float t_ = __shfl_up(P_, o_); if (lane >= o_) P_ += t_; } \
        const float T_ = __shfl(P_, 63); float c0_ = P_ - a1_, c1_ = P_; if (dir) { c0_ = T_ - c0_ + a0_; c1_ = T_ - c1_ + a1_; } \
        LAS float* o_ = sm + wid * SM_HEAD; o_[SM_CUM + 2 * lane] = c0_; o_[SM_CUM + 2 * lane + 1] = c1_; o_[SM_ECUM + 2 * lane] = __expf(c0_); o_[SM_ECUM + 2 * lane + 1] = __expf(c1_); \
        o_[SM_WST + 2 * lane] = __expf(T_ - c0_) * d0_; o_[SM_WST + 2 * lane + 1] = __expf(T_ - c1_) * d1_; o_[SM_DT + 2 * lane] = __log2f(d0_) - c0_ * 1.4426950408889634f; o_[SM_DT + 2 * lane + 1] = __log2f(d1_) - c1_ * 1.4426950408889634f; \
        if (lane == 0) sm[SM_TOT + wid] = T_; } while (0)
#pragma unroll 1
    for (int dir = 0; dir < 2; ++dir) {
        f32x16 Sacc[2];
        bf16x8 cf[8];
        u32x4 xpre[4];
        float dtn0 = 0.f, dtn1 = 0.f;
        const int dtcol = dir * 64 + 2 * hp + (wid & 1);
        const float dtb = dt_bias[dtcol];
#pragma unroll
        for (int pb = 0; pb < 2; ++pb)
#pragma unroll
            for (int r = 0; r < 16; ++r) { const int p = 32 * pb + crow32(r, hi), n = 32 * ib + r32;
                Sacc[pb][r] = s0 ? s0[(((size_t)dir * 64 + head) * 64 + p) * 128 + n] : 0.f; }
        const int rowF = row_base + (dir ? nchunks - 1 : 0) * 128;
        __syncthreads();
        { int tid_c = tid; asm volatile("" : "+v"(tid_c)); const int lane_c = tid_c & 63; (void)lane_c;
        SSD_DMA_B(rowF, 0); SSD_LOAD_X(xpre, rowF); SSD_LOAD_C(rowF);
        if (wid < 2) { dtn0 = dtraw[(size_t)(rowF + 2 * lane) * 128 + dtcol] + dtb; dtn1 = dtraw[(size_t)(rowF + 2 * lane + 1) * 128 + dtcol] + dtb; }
        { const unsigned SB = ldsb + OFF_S + hd * 16384 + (EA0 ^ (64u * ib));
#pragma unroll
          for (int pb = 0; pb < 2; ++pb)
#pragma unroll
            for (int r = 0; r < 16; ++r) *(LAS bf16_t*)(uintptr_t)((SB ^ (16u * FR_(r))) + 8192 * pb + ROWC_(r)) = (bf16_t)(cvt_pk_bf16(Sacc[pb][r], 0.f) & 0xffffu); }
        SSD_STORE_X(xpre); }
        if (wid < 2) SSD_DT_ARRAYS(dtn0, dtn1);
        VM_WAIT();
        __syncthreads();
#pragma unroll 1
        for (int cc = 0; cc < nchunks; ++cc) {
            const int chunk = dir ? nchunks - 1 - cc : cc;
            const int row0 = row_base + chunk * 128;
            const int rowN = row_base + (dir ? chunk - 1 : chunk + 1) * 128;
            const bool has_next = cc + 1 < nchunks;
            const int bsel = cc & 1;
            unsigned RA = RA0, TA = TA0, EA = EA0; asm volatile("" : "+v"(RA), "+v"(TA), "+v"(EA));
            int tid_c = tid; asm volatile("" : "+v"(tid_c)); const int lane_c = tid_c & 63;
            const unsigned yvoff = (unsigned)(r32 * SSD_DI + 64 * hd + 4 * hi) * 2u;
            const char* ybase = (const char*)Y + ((size_t)(row0 + 32 * ib) * SSD_DI + hp * 128) * 2;
            const unsigned BI = ldsb + OFF_B + bsel * 32768;
            f32x16 Yacc[2];
            const float eci = smh[SM_ECUM + 32 * ib + r32];
#pragma unroll
            for (int pb = 0; pb < 2; ++pb) { f32x16 a3 = {};
                {
#define SSD_SF(s_) (*(const LAS bf16x8*)(uintptr_t)(ldsb + OFF_S + hd * 16384 + ((RA ^ (32u * (s_))) + 8192u * pb)))
                    bf16x8 f0 = SSD_SF(0), f1 = SSD_SF(1); __builtin_amdgcn_sched_barrier(0);
                    a3 = __builtin_amdgcn_mfma_f32_32x32x16_bf16(f0, cf[0], a3, 0, 0, 0); f0 = SSD_SF(2); __builtin_amdgcn_sched_barrier(0);
                    a3 = __builtin_amdgcn_mfma_f32_32x32x16_bf16(f1, cf[1], a3, 0, 0, 0); f1 = SSD_SF(3); __builtin_amdgcn_sched_barrier(0);
                    a3 = __builtin_amdgcn_mfma_f32_32x32x16_bf16(f0, cf[2], a3, 0, 0, 0); f0 = SSD_SF(4); __builtin_amdgcn_sched_barrier(0);
                    a3 = __builtin_amdgcn_mfma_f32_32x32x16_bf16(f1, cf[3], a3, 0, 0, 0); f1 = SSD_SF(5); __builtin_amdgcn_sched_barrier(0);
                    a3 = __builtin_amdgcn_mfma_f32_32x32x16_bf16(f0, cf[4], a3, 0, 0, 0); f0 = SSD_SF(6); __builtin_amdgcn_sched_barrier(0);
                    a3 = __builtin_amdgcn_mfma_f32_32x32x16_bf16(f1, cf[5], a3, 0, 0, 0); f1 = SSD_SF(7); __builtin_amdgcn_sched_barrier(0);
                    a3 = __builtin_amdgcn_mfma_f32_32x32x16_bf16(f0, cf[6], a3, 0, 0, 0); __builtin_amdgcn_sched_barrier(0);
                    a3 = __builtin_amdgcn_mfma_f32_32x32x16_bf16(f1, cf[7], a3, 0, 0, 0); __builtin_amdgcn_sched_barrier(0);
#undef SSD_SF
                }
#pragma unroll
                for (int r = 0; r < 16; ++r) a3[r] *= eci;
                Yacc[pb] = a3; }
            if (has_next) { SSD_DMA_B(rowN, bsel ^ 1); SSD_LOAD_X(xpre, rowN);
                if (wid < 2) { dtn0 = dtraw[(size_t)(rowN + 2 * lane) * 128 + dtcol]; dtn1 = dtraw[(size_t)(rowN + 2 * lane + 1) * 128 + dtcol]; } }
            const float ci2 = smh[SM_CUM + 32 * ib + r32] * 1.4426950408889634f;
            const int i_loc = 32 * ib + r32;
            const unsigned XT = ldsb + OFF_X + (TA ^ (128u * hd));
#pragma unroll 1
            for (int jj = 0; jj < 4; ++jj) {
                const int jb = dir ? (3 - jj) : jj;
                const bool active = dir ? (jb >= ib) : (jb <= ib);
                if (active) {
                    f32x16 sc = {};
                    unsigned RAj = RA; asm volatile("" : "+v"(RAj));
#define SSD_BF(s_) (*(const LAS bf16x8*)(uintptr_t)(BI + ((RAj ^ (32u * (s_))) + 8192u * jb)))
#define SSD_SB() __builtin_amdgcn_sched_barrier(0)
                    {
                        bf16x8 f0 = SSD_BF(0), f1 = SSD_BF(1); SSD_SB();
                        sc = __builtin_amdgcn_mfma_f32_32x32x16_bf16(f0, cf[0], sc, 0, 0, 0); f0 = SSD_BF(2); SSD_SB();
                        sc = __builtin_amdgcn_mfma_f32_32x32x16_bf16(f1, cf[1], sc, 0, 0, 0); f1 = SSD_BF(3); SSD_SB();
                        sc = __builtin_amdgcn_mfma_f32_32x32x16_bf16(f0, cf[2], sc, 0, 0, 0); f0 = SSD_BF(4); SSD_SB();
                        sc = __builtin_amdgcn_mfma_f32_32x32x16_bf16(f1, cf[3], sc, 0, 0, 0); f1 = SSD_BF(5); SSD_SB();
                        sc = __builtin_amdgcn_mfma_f32_32x32x16_bf16(f0, cf[4], sc, 0, 0, 0); f0 = SSD_BF(6); SSD_SB();
                        sc = __builtin_amdgcn_mfma_f32_32x32x16_bf16(f1, cf[5], sc, 0, 0, 0); f1 = SSD_BF(7); SSD_SB();
                        sc = __builtin_amdgcn_mfma_f32_32x32x16_bf16(f0, cf[6], sc, 0, 0, 0); SSD_SB();
                        sc = __builtin_amdgcn_mfma_f32_32x32x16_bf16(f1, cf[7], sc, 0, 0, 0); SSD_SB(); }
#undef SSD_BF
                    const unsigned xb = XT + 8192u * jb;
                    s16x4 xl0[2], xh0[2], xl1[2], xh1[2];
                    xl0[0] = ds_tr_read(xb); xh0[0] = ds_tr_read((xb ^ 16u) + 1024u); xl1[0] = ds_tr_read(xb + 4096u); xh1[0] = ds_tr_read((xb ^ 16u) + 4096u + 1024u);
#pragma unroll
                    for (int rh = 0; rh < 2; ++rh) {
                        float qj[8];
#pragma unroll
                        for (int r = 0; r < 8; ++r) qj[r] = smh[SM_DT + 32 * jb + crow32(8 * rh + r, hi)];
                        SSD_SB();
#pragma unroll
                        for (int r = 0; r < 8; ++r) { const int j = 32 * jb + crow32(8 * rh + r, hi); const bool ok = dir ? (j >= i_loc) : (j <= i_loc);
                            const float wgt = __builtin_amdgcn_exp2f(ci2 + qj[r]) * sc[8 * rh + r];
                            sc[8 * rh + r] = ok ? wgt : 0.f; }
                        SSD_SB();
                    }
                    bf16x8 pa0, pa1; PK4X(sc, 0, pa0); PK4X(sc, 8, pa1);
                    xl0[1] = ds_tr_read((xb ^ 64u)); xh0[1] = ds_tr_read((xb ^ (64u + 16u)) + 1024u); xl1[1] = ds_tr_read((xb ^ 64u) + 4096u); xh1[1] = ds_tr_read((xb ^ (64u + 16u)) + 4096u + 1024u);
                    asm volatile("s_waitcnt lgkmcnt(4)" ::: "memory"); SSD_SB();
#pragma unroll
                    for (int pb = 0; pb < 2; ++pb) {
                        if (pb == 1) { asm volatile("s_waitcnt lgkmcnt(0)" ::: "memory"); SSD_SB(); }
                        Yacc[pb] = __builtin_amdgcn_mfma_f32_32x32x16_bf16((bf16x8){xl0[pb][0], xl0[pb][1], xl0[pb][2], xl0[pb][3], xh0[pb][0], xh0[pb][1], xh0[pb][2], xh0[pb][3]}, pa0, Yacc[pb], 0, 0, 0);
                        Yacc[pb] = __builtin_amdgcn_mfma_f32_32x32x16_bf16((bf16x8){xl1[pb][0], xl1[pb][1], xl1[pb][2], xl1[pb][3], xh1[pb][0], xh1[pb][1], xh1[pb][2], xh1[pb][3]}, pa1, Yacc[pb], 0, 0, 0); }
                }
            }
            if (has_next) SSD_LOAD_C(rowN);
            const unsigned zvoff = (unsigned)(r32 * SSD_ZX + 64 * hd + 4 * hi) * 2u;
            char* zbase = (char*)zx + ((size_t)(row0 + 32 * ib) * SSD_ZX + hp * 128) * 2;
            u32x2 zpre[2][4], prev[2][4];
            if (dir == 1) {
#pragma unroll
                for (int pb = 0; pb < 2; ++pb)
#pragma unroll
                    for (int g = 0; g < 4; ++g) { zpre[pb][g] = *(const u32x2*)(zbase + zvoff + (32 * pb + 8 * g) * 2); prev[pb][g] = *(const u32x2*)(ybase + yvoff + (32 * pb + 8 * g) * 2); }
            }
            {
                const float dec = __expf(sm[SM_TOT + hd]);
#pragma unroll
                for (int pb = 0; pb < 2; ++pb)
#pragma unroll
                    for (int r = 0; r < 16; ++r) Sacc[pb][r] *= dec;
                const unsigned BT = BI + (TA ^ (64u * ib));
#define P4_READ(ks_) do { bl = ds_tr_read(BT + 4096u * (ks_)); bh = ds_tr_read((BT ^ 16u) + 4096u * (ks_) + 1024u); x0l = ds_tr_read(XT + 4096u * (ks_)); x0h = ds_tr_read((XT ^ 16u) + 4096u * (ks_) + 1024u); \
                    x1l = ds_tr_read((XT ^ 64u) + 4096u * (ks_)); x1h = ds_tr_read((XT ^ (64u + 16u)) + 4096u * (ks_) + 1024u); } while (0)
                s16x4 bl, bh, x0l, x0h, x1l, x1h;
                P4_READ(0);
#pragma unroll 1
                for (int ks = 0; ks < 8; ++ks) {
                    float wj[8];
#pragma unroll
                    for (int e = 0; e < 8; ++e) wj[e] = smh[SM_WST + 16 * ks + 8 * hi + e];
                    asm volatile("s_waitcnt lgkmcnt(0)" ::: "memory"); __builtin_amdgcn_sched_barrier(0);
                    float fb[8];
#pragma unroll
                    for (int e = 0; e < 4; ++e) { fb[e] = __uint_as_float(((unsigned)(unsigned short)bl[e]) << 16) * wj[e]; fb[4 + e] = __uint_as_float(((unsigned)(unsigned short)bh[e]) << 16) * wj[4 + e]; }
                    u32x4 wb = {cvt_pk_bf16(fb[0], fb[1]), cvt_pk_bf16(fb[2], fb[3]), cvt_pk_bf16(fb[4], fb[5]), cvt_pk_bf16(fb[6], fb[7])};
                    const bf16x8 a0 = {x0l[0], x0l[1], x0l[2], x0l[3], x0h[0], x0h[1], x0h[2], x0h[3]}, a1 = {x1l[0], x1l[1], x1l[2], x1l[3], x1h[0], x1h[1], x1h[2], x1h[3]};
                    __builtin_amdgcn_sched_barrier(0);
                    Sacc[0] = __builtin_amdgcn_mfma_f32_32x32x16_bf16(a0, *reinterpret_cast<bf16x8*>(&wb), Sacc[0], 0, 0, 0);
                    Sacc[1] = __builtin_amdgcn_mfma_f32_32x32x16_bf16(a1, *reinterpret_cast<bf16x8*>(&wb), Sacc[1], 0, 0, 0);
                    __builtin_amdgcn_sched_barrier(0);
                    if (ks + 1 < 8) P4_READ(ks + 1);
                }
#undef P4_READ
            }
            {
                const unsigned XE = ldsb + OFF_X + 8192u * ib + ((256u * r32 + 16u * (((r32 & 3) << 2) | ((r32 >> 2) & 3)) + 8u * hi) ^ (128u * hd));
                if (dir == 0) {
#pragma unroll
                    for (int pb = 0; pb < 2; ++pb)
#pragma unroll
                        for (int g = 0; g < 4; ++g) {
                            const u32x2 xr = *(const LAS u32x2*)(uintptr_t)(XE ^ (16u * (4 * pb + g)));
                            const float v0 = Yacc[pb][4 * g] + dsk * bf_lo(xr.x), v1 = Yacc[pb][4 * g + 1] + dsk * bf_hi(xr.x), v2 = Yacc[pb][4 * g + 2] + dsk * bf_lo(xr.y), v3 = Yacc[pb][4 * g + 3] + dsk * bf_hi(xr.y);
                            u32x2 w; w.x = cvt_pk_bf16(v0, v1); w.y = cvt_pk_bf16(v2, v3);
                            *(u32x2*)((char*)ybase + yvoff + (32 * pb + 8 * g) * 2) = w; }
                } else {
                    asm volatile("s_waitcnt vmcnt(0)" ::: "memory");
                    float ssq = 0.f;
#pragma unroll
                    for (int pb = 0; pb < 2; ++pb)
#pragma unroll
                        for (int g = 0; g < 4; ++g) {
                            const u32x2 zq = zpre[pb][g], pq = prev[pb][g];
                            const float v0 = Yacc[pb][4 * g] + bf_lo(pq.x), v1 = Yacc[pb][4 * g + 1] + bf_hi(pq.x), v2 = Yacc[pb][4 * g + 2] + bf_lo(pq.y), v3 = Yacc[pb][4 * g + 3] + bf_hi(pq.y);
                            const float gt0 = v0 * silu_f(bf_lo(zq.x)), gt1 = v1 * silu_f(bf_hi(zq.x)), gt2 = v2 * silu_f(bf_lo(zq.y)), gt3 = v3 * silu_f(bf_hi(zq.y));
                            ssq += (gt0 * gt0 + gt1 * gt1) + (gt2 * gt2 + gt3 * gt3);
                            const f32x4 w4 = *(const LAS f32x4*)(sm + SM_NW + 64 * hd + 32 * pb + 8 * g + 4 * hi);
                            u32x2 w; w.x = cvt_pk_bf16(gt0 * w4.x, gt1 * w4.y); w.y = cvt_pk_bf16(gt2 * w4.z, gt3 * w4.w);
                            *(u32x2*)(zbase + zvoff + (32 * pb + 8 * g) * 2) = w; }
                    ssq += __shfl_xor(ssq, 32); if (hi == 0) atomicAdd(rss9 + row0 + 32 * ib + r32, rintf(ssq * 16.f) * 0.0625f);
                }
            }
            LBAR();
            { const unsigned SB = ldsb + OFF_S + hd * 16384 + (EA ^ (64u * ib));
#pragma unroll
              for (int pb = 0; pb < 2; ++pb)
#pragma unroll
                for (int r = 0; r < 16; ++r) *(LAS bf16_t*)(uintptr_t)((SB ^ (16u * FR_(r))) + 8192 * pb + ROWC_(r)) = (bf16_t)(cvt_pk_bf16(Sacc[pb][r], 0.f) & 0xffffu); }
            if (has_next) { SSD_STORE_X(xpre); if (wid < 2) SSD_DT_ARRAYS(dtn0 + dtb, dtn1 + dtb); }
            asm volatile("s_waitcnt vmcnt(9)" ::: "memory");
            LBAR();
        }
        if (sT) {
#pragma unroll
            for (int pb = 0; pb < 2; ++pb)
#pragma unroll
                for (int r = 0; r < 16; ++r) { const int p = 32 * pb + crow32(r, hi), n = 32 * ib + r32;
                    sT[(((size_t)dir * 64 + head) * 64 + p) * 128 + n] = Sacc[pb][r]; }
        }
    }
#undef FR_
#undef ROWC_
#undef SSD_SB
#undef SSD_DMA_B
#undef SSD_LOAD_X
#undef SSD_STORE_X
#undef SSD_LOAD_C
#undef SSD_DT_ARRAYS
    VM_WAIT();
    __syncthreads();
}
}

namespace lru {
constexpr int OFF_R = 0, OFF_W = 32768, OFF_A = 65536, OFF_U = 98304, OFF_AG = 132096  , OFF_UG = OFF_AG + 2048, OFF_CAR = OFF_UG + 2048  ;
__device__ __forceinline__ float sigmoid_f(float x) { return __builtin_amdgcn_rcpf(1.0f + __expf(-x)); }
__device__ __forceinline__ float gelu_tanh(float x) { const float u = 0.7978845608028654f * (x + 0.044715f * x * x * x); const float t = 1.0f - 2.0f * __builtin_amdgcn_rcpf(1.0f + __expf(2.0f * u)); return 0.5f * x * (1.0f + t); }
__device__ __forceinline__ void scan_unit(LAS unsigned char* lds, const bf16_t* gr, bf16_t* YL, const bf16_t* wg, const float* b_a, const float* b_i, const float* a_param,
                                          const float* h0  , float* hT  , int row_base, int ntiles, int nblk, int vh, const int wv_) {
    const int tid = opaque_tid(wv_), lane = tid & 63, wid = __builtin_amdgcn_readfirstlane(tid >> 6);
    const int ch0 = nblk * 128 + vh * 64;
    const int sv = lane, seg = wid;
    const unsigned lvoff = (unsigned)sv * 2u;
#pragma unroll 1
    for (int dir = 0; dir < 2; ++dir) {
        __syncthreads();
#pragma unroll
        for (int q = 0; q < 4; ++q) { const int idx = tid + 512 * q, im = idx >> 10, rem = idx & 1023, row = rem >> 4, ch = rem & 15;
            const u32x4 v = *(const u32x4*)(wg + ((size_t)((dir * 2 + im) * 16 + nblk) * 128 + vh * 64 + row) * 128 + ch * 8);
            *(LAS u32x4*)(lds + OFF_W + im * 16384 + img_off(row, ch)) = v; }
        float ba[4], bi[4], sp[4];
#pragma unroll
        for (int k = 0; k < 4; ++k) { const int ch = ch0 + k * 16 + (lane & 15);
            ba[k] = b_a[dir * 2048 + ch]; bi[k] = b_i[dir * 2048 + ch]; const float ap = -a_param[dir * 2048 + ch]; sp[k] = -8.0f * (ap > 20.f ? ap : log1pf(__expf(ap))); }
        if (tid < 64) *(LAS float*)(lds + OFF_CAR + tid * 4) = h0 ? h0[dir * 2048 + ch0 + tid] : 0.f;
        u32x4 pre[4];
        { const int tile0 = dir ? ntiles - 1 : 0; const int r0 = row_base + tile0 * 128;
#pragma unroll
          for (int q = 0; q < 4; ++q) { const int idx = tid + 512 * q, row = idx >> 4, ch = idx & 15; pre[q] = *(const u32x4*)(gr + (size_t)(r0 + row) * 4096 + 2048 + nblk * 128 + ch * 8); } }
#pragma unroll 1
        for (int tt = 0; tt < ntiles; ++tt) {
            const int tile = dir ? ntiles - 1 - tt : tt;
            const int row0 = row_base + tile * 128;
#pragma unroll
            for (int q = 0; q < 4; ++q) { const int idx = tid + 512 * q, row = idx >> 4, ch = idx & 15; *(LAS u32x4*)(lds + OFF_R + img_off(row, ch)) = pre[q]; }
            if (tt + 1 < ntiles) { const int r1 = row_base + (dir ? tile - 1 : tile + 1) * 128;
#pragma unroll
                for (int q = 0; q < 4; ++q) { const int idx = tid + 512 * q, row = idx >> 4, ch = idx & 15; pre[q] = *(const u32x4*)(gr + (size_t)(r1 + row) * 4096 + 2048 + nblk * 128 + ch * 8); } }
            unsigned pv[16], gv[16];
            if (dir == 1) {
#pragma unroll
                for (int k = 0; k < 16; ++k) { const int t = wid * 16 + 15 - k;
                    pv[k] = *(const bf16_t*)((const char*)YL + ((size_t)(row0 + t) * 2048 + ch0) * 2 + lvoff); gv[k] = *(const bf16_t*)((const char*)gr + ((size_t)(row0 + t) * 4096 + ch0) * 2 + lvoff); }
            }
            LBAR();
            {
                f32x4 accA[4] = {}, accI[4] = {};
#pragma unroll
                for (int s_ = 0; s_ < 4; ++s_) { const bf16x8 af = *(const LAS bf16x8*)(lds + OFF_R + img_row_addr16(lane, wid, s_));
#pragma unroll
                    for (int k = 0; k < 4; ++k) {
                        const bf16x8 wa = *(const LAS bf16x8*)(lds + OFF_W + img_row_addr16(lane, k, s_));
                        const bf16x8 wi = *(const LAS bf16x8*)(lds + OFF_W + 16384 + img_row_addr16(lane, k, s_));
                        accA[k] = __builtin_amdgcn_mfma_f32_16x16x32_bf16(af, wa, accA[k], 0, 0, 0);
                        accI[k] = __builtin_amdgcn_mfma_f32_16x16x32_bf16(af, wi, accI[k], 0, 0, 0); } }
#pragma unroll
                for (int k = 0; k < 4; ++k)
#pragma unroll
                    for (int r = 0; r < 4; ++r) { const int t = 16 * wid + 4 * (lane >> 4) + r, v = k * 16 + (lane & 15), wcol = vh * 64 + v;
                        const float ea = fminf(__expf(-(accA[k][r] + ba[k])), 1e18f), ei = fminf(__expf(-(accI[k][r] + bi[k])), 1e18f);
                        const float rr_ = __builtin_amdgcn_rcpf((1.0f + ea) * (1.0f + ei)), rg = rr_ * (1.0f + ei), ig = rr_ * (1.0f + ea);
                        const float a = __expf(rg * sp[k]);
                        const float rec = __uint_as_float(((unsigned)*(const LAS bf16_t*)(lds + OFF_R + img_off(t, wcol >> 3) + (wcol & 7) * 2)) << 16);
                        const float u = __builtin_amdgcn_sqrtf(fmaxf(1.0f - a * a, 0.f)) * ig * rec;
                        *(LAS f32x2*)(lds + OFF_A + (t * 64 + v) * 8) = (f32x2){a, u}; }
            }
            LBAR();
            {
                float a16[16], u16[16];
#pragma unroll
                for (int k = 0; k < 16; ++k) { const int t = seg * 16 + (dir ? 15 - k : k); const f32x2 au = *(const LAS f32x2*)(lds + OFF_A + (t * 64 + sv) * 8); a16[k] = au.x; u16[k] = au.y; }
                float Ap = 1.f, Up = 0.f;
#pragma unroll
                for (int k = 0; k < 16; ++k) { Up = a16[k] * Up + u16[k]; Ap *= a16[k]; }
                *(LAS float*)(lds + OFF_AG + (seg * 64 + sv) * 4) = Ap; *(LAS float*)(lds + OFF_UG + (seg * 64 + sv) * 4) = Up;
                LBAR();
                float h = *(const LAS float*)(lds + OFF_CAR + sv * 4);
                float ag[8], ug[8];
#pragma unroll
                for (int s2 = 0; s2 < 8; ++s2) { ag[s2] = *(const LAS float*)(lds + OFF_AG + (s2 * 64 + sv) * 4); ug[s2] = *(const LAS float*)(lds + OFF_UG + (s2 * 64 + sv) * 4); }
#pragma unroll
                for (int s2 = 0; s2 < 8; ++s2) { const int sg = dir ? 7 - s2 : s2; const bool before = dir ? (sg > seg) : (sg < seg);
                    if (before) h = ag[sg] * h + ug[sg]; }
                LBAR();
#pragma unroll
                for (int k = 0; k < 16; ++k) { const int t = wid * 16 + (dir ? 15 - k : k);
                    h = a16[k] * h + u16[k];
                    bf16_t* yp = (bf16_t*)((char*)YL + ((size_t)(row0 + t) * 2048 + ch0) * 2 + lvoff);
                    if (dir == 0) *yp = (bf16_t)(cvt_pk_bf16(h, 0.f) & 0xffffu);
                    else { const float hf = __uint_as_float(pv[k] << 16);
                        const float gt = __uint_as_float(gv[k] << 16);
                        *yp = (bf16_t)(cvt_pk_bf16((hf + h) * gelu_tanh(gt), 0.f) & 0xffffu); } }
                if (seg == (dir ? 0 : 7)) *(LAS float*)(lds + OFF_CAR + sv * 4) = h;
            }
            LBAR();
        }
        if (hT && tid < 64) hT[dir * 2048 + ch0 + tid] = *(const LAS float*)(lds + OFF_CAR + tid * 4);
    }
    VM_WAIT();
    __syncthreads();
}
}

struct Args { const float* in[36]; float* out; unsigned char* ws; int ph_lo, ph_hi; };
enum { I_XP = 0, I_XS, I_CK, I_CV, I_SSM, I_LRU, I_C, I_CCTX, I_ADAW, I_ADAB, I_NMIX, I_NFFN, I_WQKV, I_QN, I_KN, I_WO,
       I_SWIN, I_SCW, I_SCB, I_SDTB, I_SALOG, I_SD, I_SNORM, I_SWOUT, I_LWIN, I_LCW, I_LCB, I_LWA, I_LBA, I_LWI, I_LBI, I_LAP, I_LWOUT, I_FWIN, I_FWOUT, I_FNORM };

constexpr int PH_FINAL = 65, PH_END = 66;
typedef const __attribute__((address_space(4))) Args* ArgsP;
__device__ __forceinline__ ArgsP args_ptr() {
    unsigned long long p = (unsigned long long)(const __attribute__((address_space(4))) void*)__builtin_amdgcn_kernarg_segment_ptr();
    asm volatile("" : "+s"(p));
    return (ArgsP)p;
}

extern __shared__ __attribute__((aligned(16))) unsigned char lds_raw[];
#define PHASE_BEGIN() \
    int bx = blockIdx.x, G = gridDim.x; asm volatile("" : "+s"(bx), "+s"(G)); const int NGW = G * NWAVES; (void)NGW; \
    ArgsP A_ = args_ptr(); unsigned char* ws = A_->ws; float* out = A_->out; \
    unsigned ldsb_ = (unsigned)(uintptr_t)lds_raw; asm volatile("" : "+s"(ldsb_)); LAS unsigned char* lds = (LAS unsigned char*)(uintptr_t)ldsb_; \
    float* MOD = (float*)(ws + WS_MOD); bf16_t* H = (bf16_t*)(ws + WS_H); \
    (void)out; (void)lds; (void)MOD; (void)H
#define PHASE_IDS() const int tid = opaque_tid(wv_), lane = tid & 63, wave = __builtin_amdgcn_readfirstlane(tid >> 6), gw = bx * NWAVES + wave; (void)tid; (void)lane; (void)wave; (void)gw
#if MK_SINGLE
#define GRID_BAR() do { XcdBarrier b_ = bar; unsigned long long p_ = (unsigned long long)b_.bar; unsigned x_ = b_.x; asm volatile("" : "+s"(p_), "+s"(x_)); b_.bar = (unsigned*)p_; b_.x = x_; xcd_barrier(b_); } while (0)
#else
#define GRID_BAR() do { } while (0)
#endif
#define IN(k) (lo <= (k) && (k) < hi)
#define SEAM(k) do { if (IN(k) && IN((k) + 1)) GRID_BAR(); } while (0)
#define AIN(i) (A_->in[i])
#define LAYER_VALS() \
    const float* modL = MOD + (size_t)L * 9 * 12288; \
    const float* xin_p = AIN(I_XP); const float* xin_s = AIN(I_XS); bf16_t* X16 = (bf16_t*)(ws + WS_X16); (void)X16; \
    float* RSS = (float*)(ws + WS_RSS); float* BIAS = (float*)(ws + WS_BIAS); bf16_t* XG = H; \
    (void)modL; (void)xin_p; (void)xin_s; (void)RSS; (void)BIAS; (void)XG

template <int L> __device__ __forceinline__ void layer_phases(const int lo, const int hi, const XcdBarrier& bar, const int wv_) {

    constexpr int base = 1 + 16 * L, kind = L % 3, jm = L / 3;
        if (L == 0) {
            if (IN(base + 0) && EN(1)) {
                PHASE_BEGIN(); PHASE_IDS(); LAYER_VALS();
                _Pragma("unroll 1") for (int rep_ = 0; rep_ < REP_NORM; ++rep_) {
                const int gwi = wave * G + bx;
                bias_mat(lds, (const bf16_t*)(ws + W_QKV), NQKV, MOD + (size_t)0 * 9 * 12288, BIAS + BO_QKV, gwi, NGW, tid, lane, 0);
                bias_mat(lds, (const bf16_t*)(ws + W_QKV + W_QKV_SZ), NQKV, MOD + (size_t)3 * 9 * 12288, BIAS + BO_QKV + 9 * NQKV, gwi, NGW, tid, lane, 192);
                bias_mat(lds, (const bf16_t*)(ws + W_SSDIN), SSD_NPAD, MOD + (size_t)1 * 9 * 12288, BIAS + BO_SSD, gwi, NGW, tid, lane, 384);
                bias_mat(lds, (const bf16_t*)(ws + W_LRUIN), 4096, MOD + (size_t)2 * 9 * 12288, BIAS + BO_LRU, gwi, NGW, tid, lane, 1040);
                _Pragma("unroll 1") for (int l = 0; l < 4; ++l)
                    bias_mat(lds, (const bf16_t*)(ws + W_FFNIN + l * W_FFNIN_SZ), NFFN, MOD + (size_t)l * 9 * 12288 + 3 * 2048, BIAS + BO_FFN + l * BO_FFN_SZ, gwi, NGW, tid, lane, 1296 + l * 704);
                { float* GM = (float*)(ws + WS_GM);
                  for (int i = bx * NTHREADS + tid; i < 4 * 2 * 9 * 2048; i += G * NTHREADS) { const int k = i & 2047, ci2 = (i >> 11) % 9, sl = (i >> 11) / 9, l = sl >> 1, sb = sl & 1;
                      float gm = (sb ? AIN(I_NFFN) : AIN(I_NMIX))[l * DM + k] * (1.0f + MOD[((size_t)l * 9 + ci2) * 12288 + (sb ? 4 : 1) * 2048 + k]);
                      if (!(fabsf(gm) >= 9.5367431640625e-07f)) gm = copysignf(9.5367431640625e-07f, gm);
                      GM[i] = gm; ((float*)(ws + WS_RGM))[i] = 1.0f / gm; } }
                xg_init_pass(xin_p, xin_s, AIN(I_NMIX), modL, 2048, XG, RSS, gw, NGW, lane);
                __syncthreads();
                }
            }
            SEAM(base + 0);
        }
        if (kind == 0) {
#define ATT_BUFS() bf16_t* QKV = (bf16_t*)(ws + B_QKV); bf16_t* OB = (bf16_t*)(ws + B_O); bf16_t* KS = (bf16_t*)(ws + B_KS); bf16_t* VS = (bf16_t*)(ws + B_VS); \
            bf16_t* KP = (bf16_t*)(ws + B_KP); bf16_t* VP = (bf16_t*)(ws + B_VP); (void)QKV; (void)OB; (void)KS; (void)VS; (void)KP; (void)VP
            if (IN(base + 1) && EN(2)) {
                PHASE_BEGIN(); ATT_BUFS(); LAYER_VALS();
                pg8::Gemm g{XG, (const bf16_t*)(ws + W_QKV + jm * W_QKV_SZ), MT, NQKV, DM, DM}; pg8::StaticOrder S; S.init(MT, NQKV, G, bx);
                pg8::EpiBf16 E{QKV, NQKV, nullptr, 0, 0, pg8::RowMod{RSS + (size_t)(2 * L) * MT, BIAS + BO_QKV + jm * 9 * NQKV, NQKV}};
                pg8::gemm_phase<pg8::EpiBf16, pg8::StaticOrder, true, true>(lds, g, S, E, wv_);
#if REP_QKV > 1
                pg8::gemm_phase<pg8::EpiBf16, pg8::StaticOrder, true, true>(lds, g, S, E, wv_);
#endif
            }
            SEAM(base + 1);
            if (IN(base + 2) && EN(3)) {
                PHASE_BEGIN(); PHASE_IDS(); ATT_BUFS();
                const float* kn = AIN(I_KN) + jm * 128;
                const int grp = lane >> 4, sub = lane & 15;
                float kw[8];
#pragma unroll
                for (int e = 0; e < 8; ++e) kw[e] = kn[sub * 8 + e];
                const f32x2* rope = (const f32x2*)(ws + WS_ROPE);
                constexpr int RB = 3;
                for (int row0 = gw; row0 < MT; row0 += RB * NGW) {
                    u32x4 rawk[RB], rawv[RB]; f32x4 rpf[RB][4];
#pragma unroll
                    for (int j = 0; j < RB; ++j) { const int row = row0 + j * NGW; if (row < MT) {
                        const bool samp = row >= MP; const int t = samp ? ((row - MP) & 4095) : (row & 255);
                        const bf16_t* qrow = QKV + (size_t)row * NQKV;
                        rawk[j] = *(const u32x4*)(qrow + 2048 + grp * 128 + sub * 8); if (!samp) rawv[j] = *(const u32x4*)(qrow + 2560 + lane * 8);
                        const int i0 = 8 * (sub & 7); const int pos = (i0 < 32) ? (t >> 6) : (t & 63); const f32x4* rp = (const f32x4*)(rope + pos * 32 + (i0 & 31));
#pragma unroll
                        for (int q4 = 0; q4 < 4; ++q4) rpf[j][q4] = rp[q4]; } }
                    asm volatile("" ::: "memory");
#pragma unroll
                    for (int j = 0; j < RB; ++j) { const int row = row0 + j * NGW; if (row < MT) {
                        const bool samp = row >= MP;
                        const int b = samp ? ((row - MP) >> 12) : (row >> 8), t = samp ? ((row - MP) & 4095) : (row & 255);
                        {
                            const u32x4 raw = rawk[j];
                            float v[8] = {bf_lo(raw.x), bf_hi(raw.x), bf_lo(raw.y), bf_hi(raw.y), bf_lo(raw.z), bf_hi(raw.z), bf_lo(raw.w), bf_hi(raw.w)};
                            float ss = 0.f;
#pragma unroll
                            for (int e = 0; e < 8; ++e) ss += v[e] * v[e];
                            ss += __shfl_xor(ss, 1); ss += __shfl_xor(ss, 2); ss += __shfl_xor(ss, 4); ss += __shfl_xor(ss, 8);
                            const float rstd = 1.0f / sqrtf(ss * (1.0f / 128.0f) + EPS);
#pragma unroll
                            for (int e = 0; e < 8; ++e) v[e] = v[e] * rstd * kw[e];
                            float r[8];
                            if (!samp) {
                                float* ck = out + O_CK + (((size_t)(b * 2 + jm) * 256 + t) * 512 + grp * 128 + sub * 8);
                                *(f32x4*)ck = (f32x4){v[0], v[1], v[2], v[3]}; *(f32x4*)(ck + 4) = (f32x4){v[4], v[5], v[6], v[7]};
                            }
#pragma unroll
                            for (int e = 0; e < 8; ++e) { const float cs = samp ? rpf[j][e >> 1][(e & 1) * 2] : 1.f, sn = samp ? rpf[j][e >> 1][(e & 1) * 2 + 1] : 0.f;
                                const float p = __shfl_xor(v[e], 8); r[e] = (sub < 8) ? v[e] * cs - p * sn : v[e] * cs + p * sn; }
                            u32x4 w; w.x = cvt_pk_bf16(r[0], r[1]); w.y = cvt_pk_bf16(r[2], r[3]); w.z = cvt_pk_bf16(r[4], r[5]); w.w = cvt_pk_bf16(r[6], r[7]);
                            bf16_t* kd = samp ? KS + ((size_t)(b * LKS + t) * 512) : KP + (size_t)row * 512; *(u32x4*)(kd + grp * 128 + sub * 8) = w;
                        }
                        if (!samp) {
                            const u32x4 raw = rawv[j];
                            float* cv = out + O_CV + (((size_t)(b * 2 + jm) * 256 + t) * 512 + lane * 8);
                            *(f32x4*)cv = (f32x4){bf_lo(raw.x), bf_hi(raw.x), bf_lo(raw.y), bf_hi(raw.y)}; *(f32x4*)(cv + 4) = (f32x4){bf_lo(raw.z), bf_hi(raw.z), bf_lo(raw.w), bf_hi(raw.w)};
                        } } }
                }
                for (int r = gw; r < 2 * 8 * PAST; r += NGW) {
                    const int which = r / (8 * PAST), rr = r % (8 * PAST), b = rr / PAST, sidx = rr % PAST;
                    const float* src = (which ? AIN(I_CV) : AIN(I_CK)) + (((size_t)(b * 2 + jm) * PAST + sidx) * 512) + lane * 8;
                    const f32x4 a0 = *(const f32x4*)src, a1 = *(const f32x4*)(src + 4);
                    u32x4 w; w.x = cvt_pk_bf16(a0.x, a0.y); w.y = cvt_pk_bf16(a0.z, a0.w); w.z = cvt_pk_bf16(a1.x, a1.y); w.w = cvt_pk_bf16(a1.z, a1.w);
                    if (which) *(u32x4*)(VS + ((size_t)(b * PAST + sidx) * att::LDV) + lane * 8) = w;
                    else *(u32x4*)(KS + ((size_t)(b * LKS + 4096 + sidx) * 512) + lane * 8) = w;
                }
            }
            SEAM(base + 2);
            if (IN(base + 3) && EN(4)) {
                PHASE_BEGIN(); ATT_BUFS();
                _Pragma("unroll 1") for (int rep_ = 0; rep_ < REP_ATT; ++rep_)
#pragma unroll 1
                for (int i = 0; i * G + bx < 2048 + 256; ++i) {
                    const int lin = i * G + bx; int uid = lin;
                    if (G == 256 && lin < 2048) { const int xcd = bx & 7, slot = bx >> 3; uid = (xcd + 8 * (i >> 1)) * 64 + (i & 1) * 32 + slot; }
                    const bf16_t *qp, *kp, *vp, *vc; bf16_t* op; int seq, tok0, nown;
                    if (uid < 2048) {
                        const int gi = uid >> 6, w = uid & 63, b = gi >> 2, kvh = gi & 3, h = kvh * 4 + (w >> 4), qb = w & 15;
                        const size_t qrow0 = (size_t)MP + (size_t)b * 4096 + qb * 256;
                        qp = QKV + qrow0 * NQKV + h * 128; kp = KS + (size_t)b * LKS * 512 + kvh * 128; vp = QKV + ((size_t)MP + (size_t)b * 4096) * NQKV + 2560 + kvh * 128; vc = VS + (size_t)b * PAST * att::LDV + kvh * 128; nown = 4096 / 64; op = OB + qrow0 * DM + h * 128; seq = LKS; tok0 = qb * 256;
                    } else {
                        const int p = uid - 2048, b = p >> 4, h = p & 15, kvh = h >> 2;
                        const size_t qrow0 = (size_t)b * 256;
                        qp = QKV + qrow0 * NQKV + h * 128; kp = KP + qrow0 * 512 + kvh * 128; vp = QKV + qrow0 * NQKV + 2560 + kvh * 128; vc = vp; nown = 256 / 64; op = OB + qrow0 * DM + h * 128; seq = 256; tok0 = -1;
                    }
                    att::attn_dma_body(qp, kp, vp, op, seq, lds, wv_, AIN(I_QN) + jm * 128, (const f32x2*)(ws + WS_ROPE), tok0, vc, nown);
                }
            }
            SEAM(base + 3);
            if (IN(base + 4) && EN(5)) {
                PHASE_BEGIN(); ATT_BUFS(); LAYER_VALS();
                pg8::Gemm g{OB, (const bf16_t*)(ws + W_O + jm * W_O_SZ), MT, DM, DM, DM}; pg8::StaticOrder S; S.init(MT, DM, G, bx, WGM_N2048);
                pg8::EpiResid<L == 0> E{xin_p, xin_s, X16, modL + 2 * 2048, XG, XG, (const float*)(ws + WS_GM) + (size_t)((L * 2 + 1) * 9) * 2048, (const float*)(ws + WS_RGM) + (size_t)((L * 2 + 0) * 9) * 2048, RSS + (size_t)(2 * L + 1) * MT, nullptr, 0.f};
                pg8::gemm_phase<decltype(E), pg8::StaticOrder, true, true>(lds, g, S, E, wv_);
            }
            SEAM(base + 4);
        } else if (kind == 1) {
#define SSD_BUFS() bf16_t* ZX = (bf16_t*)(ws + B_ZX); bf16_t* YB = (bf16_t*)(out + O_X); bf16_t* halo = (bf16_t*)(ws + WS_HALO); float* DT = (float*)(ws + WS_DT); (void)ZX; (void)YB; (void)halo; (void)DT
            if (IN(base + 1) && EN(6)) {
                PHASE_BEGIN(); SSD_BUFS(); LAYER_VALS();
                pg8::Gemm g{XG, (const bf16_t*)(ws + W_SSDIN), MT, SSD_NPAD, DM, DM}; pg8::StaticOrder S; S.init(MT, SSD_NPAD, G, bx);
                pg8::EpiSsdIn E{ZX, halo, DT, pg8::RowMod{RSS + (size_t)(2 * L) * MT, BIAS + BO_SSD, SSD_NPAD}};
                pg8::gemm_phase<pg8::EpiSsdIn, pg8::StaticOrder, true, true>(lds, g, S, E, wv_);
#if REP_SSDIN > 1
                pg8::gemm_phase<pg8::EpiSsdIn, pg8::StaticOrder, true, true>(lds, g, S, E, wv_);
#endif
            }
            SEAM(base + 1);
            if (IN(base + 2) && EN(7)) { PHASE_BEGIN(); PHASE_IDS(); SSD_BUFS(); conv_inplace<true>(ZX, SSD_ZX, SSD_DI, SSD_XBC, halo, AIN(I_SCW), AIN(I_SCB), ((tid >> 6) * G + bx) * 64 + (tid & 63), G * NTHREADS); }
            SEAM(base + 2);
            if (IN(base + 3) && EN(8)) {
                PHASE_BEGIN(); SSD_BUFS();
_Pragma("unroll 1") for (int rep_ = 0; rep_ < REP_SSDSCAN; ++rep_)
#pragma unroll 1
                for (int u = bx; u < 256 + 512; u += G) {
                    const bool samp = u < 256; const int p0_ = samp ? u : u - 256, p = (G == 256) ? (samp ? (p0_ & 7) * 32 + (p0_ >> 3) : (p0_ & 7) * 64 + (p0_ >> 3)) : p0_, b = p >> 5, hp = p & 31;
                    const float* s0 = samp ? AIN(I_SSM) + (size_t)b * 2 * 64 * 8192 : nullptr;
                    float* sT = samp ? nullptr : out + O_SSM + (size_t)b * 2 * 64 * 8192;
                    ssd::scan_unit(lds, ZX, DT, YB, AIN(I_SDTB), AIN(I_SALOG), AIN(I_SD), AIN(I_SNORM), (float*)(ws + WS_RSS) + (size_t)9 * MT, s0, sT, samp ? MP + b * 4096 : b * 256, samp ? 32 : 2, hp, wv_);
                }
            }
            SEAM(base + 3);
            if (IN(base + 4) && EN(10)) {
                PHASE_BEGIN(); SSD_BUFS(); LAYER_VALS();
                pg8::Gemm g{ZX, (const bf16_t*)(ws + W_SSDOUT), MT, DM, SSD_DI, SSD_ZX}; pg8::StaticOrder S; S.init(MT, DM, G, bx, WGM_N2048);
                pg8::EpiResid<L == 0> E{xin_p, xin_s, X16, modL + 2 * 2048, XG, XG, (const float*)(ws + WS_GM) + (size_t)((L * 2 + 1) * 9) * 2048, (const float*)(ws + WS_RGM) + (size_t)((L * 2 + 0) * 9) * 2048, RSS + (size_t)(2 * L + 1) * MT, RSS + (size_t)9 * MT, 1.0f / SSD_DI};
                pg8::gemm_phase<decltype(E), pg8::StaticOrder, true, true>(lds, g, S, E, wv_);
            }
            SEAM(base + 4);
        } else {
#define LRU_BUFS() bf16_t* GR = (bf16_t*)(ws + B_GR); bf16_t* YL = (bf16_t*)(ws + B_YL); bf16_t* halo = (bf16_t*)(ws + WS_HALO); (void)GR; (void)YL; (void)halo
            if (IN(base + 1) && EN(11)) {
                PHASE_BEGIN(); LRU_BUFS(); LAYER_VALS();
                pg8::Gemm g{XG, (const bf16_t*)(ws + W_LRUIN), MT, 4096, DM, DM}; pg8::StaticOrder S; S.init(MT, 4096, G, bx);
                pg8::EpiBf16 E{GR, 4096, halo, 2048, 2048, pg8::RowMod{RSS + (size_t)(2 * L) * MT, BIAS + BO_LRU, 4096}};
                pg8::gemm_phase<pg8::EpiBf16, pg8::StaticOrder, true, true>(lds, g, S, E, wv_);
            }
            SEAM(base + 1);
            if (IN(base + 2) && EN(7)) { PHASE_BEGIN(); PHASE_IDS(); LRU_BUFS(); conv_inplace<false>(GR, 4096, 2048, 2048, halo, AIN(I_LCW), AIN(I_LCB), ((tid >> 6) * G + bx) * 64 + (tid & 63), G * NTHREADS); }
            SEAM(base + 2);
            if (IN(base + 3) && EN(12)) {
                PHASE_BEGIN(); LRU_BUFS();
_Pragma("unroll 1") for (int rep_ = 0; rep_ < REP_LRUSCAN; ++rep_)
#pragma unroll 1
                for (int u = bx; u < 256 + 512; u += G) {
                    const bool samp = u < 256; const int p0_ = samp ? u : u - 256, p = (G == 256) ? (samp ? (p0_ & 7) * 32 + (p0_ >> 3) : (p0_ & 7) * 64 + (p0_ >> 3)) : p0_, b = p >> 5, nb = (p >> 1) & 15, vh = p & 1;
                    const float* h0 = samp ? AIN(I_LRU) + (size_t)b * 2 * 2048 : nullptr;
                    float* hT = samp ? nullptr : out + O_LRU + (size_t)b * 2 * 2048;
                    lru::scan_unit(lds, GR, YL, (const bf16_t*)(ws + W_LRUG), AIN(I_LBA), AIN(I_LBI), AIN(I_LAP), h0, hT, samp ? MP + b * 4096 : b * 256, samp ? 32 : 2, nb, vh, wv_);
                }
            }
            SEAM(base + 3);
            if (IN(base + 4) && EN(13)) {
                PHASE_BEGIN(); LRU_BUFS(); LAYER_VALS();
                pg8::Gemm g{YL, (const bf16_t*)(ws + W_LRUOUT), MT, DM, DM, DM}; pg8::StaticOrder S; S.init(MT, DM, G, bx, WGM_N2048);
                pg8::EpiResid<L == 0> E{xin_p, xin_s, X16, modL + 2 * 2048, XG, XG, (const float*)(ws + WS_GM) + (size_t)((L * 2 + 1) * 9) * 2048, (const float*)(ws + WS_RGM) + (size_t)((L * 2 + 0) * 9) * 2048, RSS + (size_t)(2 * L + 1) * MT, nullptr, 0.f};
                pg8::gemm_phase<decltype(E), pg8::StaticOrder, true, true>(lds, g, S, E, wv_);
            }
            SEAM(base + 4);
        }
        if (IN(base + 11) && EN(14)) {
            PHASE_BEGIN(); LAYER_VALS();
            pg8::Gemm g{XG, (const bf16_t*)(ws + W_FFNIN + L * W_FFNIN_SZ), MT, NFFN, DM, DM}; pg8::StaticOrder S; S.init(MT, NFFN, G, bx, WGM_FFN1);
            pg8::EpiSwiGLU E{(bf16_t*)(ws + B_ACT), pg8::RowMod{RSS + (size_t)(2 * L + 1) * MT, BIAS + BO_FFN + L * BO_FFN_SZ, NFFN}};
            pg8::gemm_phase<pg8::EpiSwiGLU, pg8::StaticOrder, true, true>(lds, g, S, E, wv_);
#if REP_FFN1 > 1
            pg8::gemm_phase<pg8::EpiSwiGLU, pg8::StaticOrder, true, true>(lds, g, S, E, wv_);
#endif
        }
        SEAM(base + 11);
        if (IN(base + 12) && EN(15)) {
            PHASE_BEGIN(); LAYER_VALS();
            pg8::Gemm g{(const bf16_t*)(ws + B_ACT), (const bf16_t*)(ws + W_FFNOUT + L * W_FFNOUT_SZ), MT, DM, DFF, DFF}; pg8::StaticOrder S; S.init(MT, DM, G, bx, WGM_N2048);
            pg8::EpiResid<false> E{nullptr, nullptr, X16, modL + 5 * 2048, XG, (L < 3) ? XG : nullptr, (const float*)(ws + WS_GM) + (size_t)(((L < 3 ? L + 1 : 0) * 2 + 0) * 9) * 2048, (const float*)(ws + WS_RGM) + (size_t)((L * 2 + 1) * 9) * 2048, RSS + (size_t)(2 * L + 2) * MT, nullptr, 0.f};
            pg8::gemm_phase<decltype(E), pg8::StaticOrder, true, true>(lds, g, S, E, wv_);
        }
        SEAM(base + 12);
    }

__global__ void __launch_bounds__(NTHREADS, 2) fwd_kernel(Args args) {
    const int wv_ = __builtin_amdgcn_readfirstlane((int)(threadIdx.x >> 6));
    for (int u = threadIdx.x; u < (LDS_BYTES - RING_BYTES) / 4; u += NTHREADS) ((LAS unsigned*)((LAS unsigned char*)lds_raw + RING_BYTES))[u] = 0u;
    __syncthreads();
#if MK_SINGLE
    XcdBarrier bar = xcd_barrier_post((unsigned*)(args.ws + WS_CTL) + CW_BAR, (volatile LAS unsigned*)((LAS unsigned char*)lds_raw + MISC_OFF) + 8, wv_);
#else
    XcdBarrier bar; bar.bar = nullptr; bar.x = 0; bar.st = nullptr; bar.wv = wv_;
#endif
    const int lo = args.ph_lo, hi = args.ph_hi;

    if (IN(0) && EN(0)) {
        PHASE_BEGIN(); PHASE_IDS();
        _Pragma("unroll 1") for (int rep_ = 0; rep_ < REP_P0; ++rep_) {
        {
            LAS float* tab = (LAS float*)lds;
            LAS float* red = (LAS float*)(lds + 9 * 2048 * 4);
            const float* cvec = AIN(I_C); const float* cctx = AIN(I_CCTX);
            for (int i = tid; i < 9 * 2048; i += NTHREADS) { const int ci = i >> 11, k = i & 2047; const float c = ci < 8 ? cvec[ci * 2048 + k] : cctx[k]; tab[i] = c / (1.0f + expf(-c)); }
            __syncthreads();
            for (int unit = bx; unit < 4 * 192; unit += G) {
                const int layer = unit / 192, cb = unit % 192;
                const float* Wp = AIN(I_ADAW) + (size_t)layer * 2048 * 12288 + cb * 64 + lane;
                float acc[9];
#pragma unroll
                for (int c = 0; c < 9; ++c) acc[c] = 0.f;
                const int k0 = wave * 256;
#pragma unroll 32
                for (int kk = 0; kk < 256; ++kk) { const float wv = Wp[(size_t)(k0 + kk) * 12288];
#pragma unroll
                    for (int c = 0; c < 9; ++c) acc[c] += tab[c * 2048 + k0 + kk] * wv; }
#pragma unroll
                for (int c = 0; c < 9; ++c) red[(wave * 9 + c) * 64 + lane] = acc[c];
                __syncthreads();
                for (int o = tid; o < 576; o += NTHREADS) { const int c = o >> 6, l = o & 63; float sacc = 0.f;
#pragma unroll
                    for (int w = 0; w < 8; ++w) sacc += red[(w * 9 + c) * 64 + l];
                    MOD[((size_t)layer * 9 + c) * 12288 + cb * 64 + l] = sacc + AIN(I_ADAB)[layer * 12288 + cb * 64 + l]; }
                __syncthreads();
            }
        }
        {
            f32x2* rope = (f32x2*)(ws + WS_ROPE);
            for (int i = bx * NTHREADS + tid; i < 64 * 32; i += G * NTHREADS) { const int pos = i >> 5, f = i & 31;
                const float inv = exp2f(-(float)f * (13.287712379549449f / 32.0f));
                const float ang = (float)pos * inv;
                const double a = (double)ang, tw = 6.283185307179586476925;
                const double r = a - tw * __builtin_rint(a / tw);
                rope[i] = (f32x2){__cosf((float)r), __sinf((float)r)}; }
        }
        {
            __syncthreads();
            LAS float* scr = (LAS float*)(lds + wave * 16384);
            const int gwi = wave * G + bx; int toff = 0;
            for (int j = 0; j < 2; ++j) {
                transpose_mat<0>(AIN(I_WQKV) + (size_t)j * DM * NQKV, NQKV, DM, (bf16_t*)(ws + W_QKV + j * W_QKV_SZ), NQKV, scr, gwi, NGW, lane, toff);
                transpose_mat<0>(AIN(I_WO) + (size_t)j * DM * DM, DM, DM, (bf16_t*)(ws + W_O + j * W_O_SZ), DM, scr, gwi, NGW, lane, toff);
            }
            transpose_mat<2>(AIN(I_SWIN), 10368, DM, (bf16_t*)(ws + W_SSDIN), SSD_NPAD, scr, gwi, NGW, lane, toff);
            transpose_mat<0>(AIN(I_SWOUT), DM, SSD_DI, (bf16_t*)(ws + W_SSDOUT), DM, scr, gwi, NGW, lane, toff);
            transpose_mat<0>(AIN(I_LWIN), 4096, DM, (bf16_t*)(ws + W_LRUIN), 4096, scr, gwi, NGW, lane, toff);
            transpose_mat<0>(AIN(I_LWOUT), DM, DM, (bf16_t*)(ws + W_LRUOUT), DM, scr, gwi, NGW, lane, toff);
            for (int blk = 0; blk < 64; ++blk) {
                const int d = blk >> 5, gate = (blk >> 4) & 1, n = blk & 15;
                const float* src = (gate ? AIN(I_LWI) : AIN(I_LWA)) + ((size_t)(d * 16 + n)) * 128 * 128;
                transpose_mat<0>(src, 128, 128, (bf16_t*)(ws + W_LRUG) + (size_t)blk * 128 * 128, 128, scr, gwi, NGW, lane, toff);
            }
            for (int l = 0; l < 4; ++l) {
                transpose_mat<1>(AIN(I_FWIN) + (size_t)l * DM * NFFN, NFFN, DM, (bf16_t*)(ws + W_FFNIN + l * W_FFNIN_SZ), NFFN, scr, gwi, NGW, lane, toff);
                transpose_mat<0>(AIN(I_FWOUT) + (size_t)l * DFF * DM, DM, DFF, (bf16_t*)(ws + W_FFNOUT + l * W_FFNOUT_SZ), DM, scr, gwi, NGW, lane, toff);
            }
            __syncthreads();
        }
        }
    }
    SEAM(0);

    layer_phases<0>(lo, hi, bar, wv_); layer_phases<1>(lo, hi, bar, wv_); layer_phases<2>(lo, hi, bar, wv_); layer_phases<3>(lo, hi, bar, wv_);
    if (IN(PH_FINAL) && EN(16)) {
        PHASE_BEGIN(); PHASE_IDS();
        const float* fn = AIN(I_FNORM); const float* rss = (const float*)(ws + WS_RSS) + (size_t)8 * MT; const bf16_t* X16 = (const bf16_t*)(ws + WS_X16);
        for (int row = gw; row < MT; row += NGW) {
            const u32x4* x8 = (const u32x4*)(X16 + (size_t)row * DM) + lane; f32x4* y4 = (f32x4*)(out + O_X + (size_t)row * DM) + 2 * lane;
            const float rstd = 1.0f / sqrtf(rss[row] * (1.0f / DM) + EPS);
            u32x4 v[4];
#pragma unroll
            for (int j = 0; j < 4; ++j) v[j] = x8[64 * j];
#pragma unroll
            for (int j = 0; j < 4; ++j) { const f32x4 g0 = ((const f32x4*)fn)[128 * j + 2 * lane], g1 = ((const f32x4*)fn)[128 * j + 2 * lane + 1];
                const f32x4 a = {bf_lo(v[j].x), bf_hi(v[j].x), bf_lo(v[j].y), bf_hi(v[j].y)}, b = {bf_lo(v[j].z), bf_hi(v[j].z), bf_lo(v[j].w), bf_hi(v[j].w)};
                y4[128 * j] = a * rstd * g0; y4[128 * j + 1] = b * rstd * g1; }
        }
    }
}

extern "C" void kernel_launch(void* const* d_in, const int* in_sizes, int n_in, void* d_out, int out_size, void* d_ws, size_t ws_size, hipStream_t stream) {
    static int grid = 0;
    if (grid == 0) {
        if (n_in != 36 || (size_t)out_size != O_END || ws_size < WS_END) { fprintf(stderr, "kernel_launch: shape mismatch n_in %d out %d ws %zu (need %zu)\n", n_in, out_size, ws_size, (size_t)WS_END); grid = -1; return; }
        int dev = 0, cus = 0, per_cu = 0;
        if (hipGetDevice(&dev) != hipSuccess || hipDeviceGetAttribute(&cus, hipDeviceAttributeMultiprocessorCount, dev) != hipSuccess) { grid = -1; return; }
        if (hipFuncSetAttribute((const void*)fwd_kernel, hipFuncAttributeMaxDynamicSharedMemorySize, LDS_BYTES) != hipSuccess) { fprintf(stderr, "kernel_launch: hipFuncSetAttribute failed\n"); grid = -1; return; }
        if (hipOccupancyMaxActiveBlocksPerMultiprocessor(&per_cu, (const void*)fwd_kernel, NTHREADS, LDS_BYTES) != hipSuccess || per_cu < 1)
            fprintf(stderr, "kernel_launch: occupancy query reports %d\n", per_cu);
        (void)hipGetLastError();
        grid = cus;
    }
    if (grid < 0) return;
    (void)hipMemsetAsync((char*)d_ws + WS_CTL, 0, CTL_ZERO_BYTES, stream);
    (void)hipMemsetAsync((char*)d_ws + WS_RSS, 0, RSS_BYTES, stream);
    Args a{};
    for (int i = 0; i < 36; ++i) a.in[i] = (const float*)d_in[i];
    a.out = (float*)d_out; a.ws = (unsigned char*)d_ws;
#if MK_SINGLE
    a.ph_lo = 0; a.ph_hi = PH_END;
    hipLaunchKernelGGL(fwd_kernel, dim3(grid), dim3(NTHREADS), LDS_BYTES, stream, a);
#else
    static const int phases[] = {0,
        1, 2, 3, 4, 5, 12, 13,
        18, 19, 20, 21, 28, 29,
        34, 35, 36, 37, 44, 45,
        50, 51, 52, 53, 60, 61,
        65};
    for (unsigned i = 0; i < sizeof(phases) / sizeof(phases[0]); ++i) {
        a.ph_lo = phases[i]; a.ph_hi = phases[i] + 1;
        hipLaunchKernelGGL(fwd_kernel, dim3(grid), dim3(NTHREADS), LDS_BYTES, stream, a);
    }
#endif
}
```
